# Optimizing an MI355X kernel written in HIP

```python
import math
import jax, jax.numpy as jnp
from jax import lax
import numpy as np

D_MODEL = 2048
BATCH = 2
SEQ = 8192
DEPTH = 4

N_MIXERS = 3
ROPE_THETA = 10000.0
EPS = 1e-6
NEG = -1e30

DA_QK_DIM = 128
DA_V_DIM = 2 * DA_QK_DIM
DA_HEADS = D_MODEL // DA_V_DIM
DA_WIDTH = DA_HEADS * DA_V_DIM
DA_QBLOCK = 128
DA_IN = 2 * DA_HEADS * DA_QK_DIM * 2 + DA_WIDTH + DA_WIDTH

SW_HEAD_DIM = 64
SW_Q_HEADS = D_MODEL // SW_HEAD_DIM
SW_KV_HEADS = SW_Q_HEADS // 8
SW_GROUP = SW_Q_HEADS // SW_KV_HEADS
SW_WIDTH = SW_Q_HEADS * SW_HEAD_DIM
WINDOW = 128
SW_IN = SW_WIDTH + 2 * SW_KV_HEADS * SW_HEAD_DIM + SW_WIDTH

ML_HEADS = 8
ML_V_DIM = D_MODEL // ML_HEADS
ML_QK_DIM = ML_V_DIM // 2
ML_WIDTH = ML_HEADS * ML_V_DIM
ML_CHUNK = 64
ML_IN = 2 * ML_HEADS * ML_QK_DIM + ML_WIDTH + ML_WIDTH + 2 * ML_HEADS + ML_WIDTH

N_A = (DEPTH + 2) // 3
N_B = (DEPTH + 1) // 3
N_C = DEPTH // 3

kernel_name = "hybrid_diffattn_swa_sink_mlstm_gated"


def rmsnorm(x, g):
    xf = x.astype(jnp.float32)
    y = xf * lax.rsqrt(jnp.mean(xf * xf, axis=-1, keepdims=True) + EPS)
    return (y * g.astype(jnp.float32)).astype(x.dtype)


def rope_tables(positions, dim):
    inv_freq = ROPE_THETA ** (-jnp.arange(0, dim, 2, dtype=jnp.float32) / dim)
    ang = positions.astype(jnp.float32)[..., None] * inv_freq
    return jnp.cos(ang)[:, :, None, :], jnp.sin(ang)[:, :, None, :]


def rope(x, cos, sin):
    half = x.shape[-1] // 2
    x1, x2 = x[..., :half], x[..., half:]
    return jnp.concatenate([x1 * cos - x2 * sin, x2 * cos + x1 * sin], axis=-1).astype(x.dtype)


def diff_attention(h, w_in, w_out, lam, subln_g, cos, sin, lambda_init):
    B, S, _ = h.shape
    H, d, dv = DA_HEADS, DA_QK_DIM, DA_V_DIM
    nq = 2 * H * d
    proj = h @ w_in
    q, k, v, g = jnp.split(proj, [nq, 2 * nq, 2 * nq + DA_WIDTH], axis=-1)
    q = rope(q.reshape(B, S, 2 * H, d), cos, sin) * (d ** -0.5)
    k = rope(k.reshape(B, S, 2 * H, d), cos, sin)
    q = q.reshape(B, S, H, 2, d).transpose(0, 2, 3, 1, 4)
    k = k.reshape(B, S, H, 2, d).transpose(0, 2, 3, 1, 4)
    v = v.reshape(B, S, H, dv).transpose(0, 2, 1, 3)
    lamf = lam.astype(jnp.float32)
    lam_full = (jnp.exp(jnp.sum(lamf[0] * lamf[1])) - jnp.exp(jnp.sum(lamf[2] * lamf[3])) + lambda_init)
    nb = S // DA_QBLOCK
    qb = q.reshape(B, H, 2, nb, DA_QBLOCK, d).transpose(3, 0, 1, 2, 4, 5)
    kpos = jnp.arange(S)

    def attend(args):
        qblk, blk = args
        s = jnp.einsum('bhmqd,bhmkd->bhmqk', qblk, k, preferred_element_type=jnp.float32)
        qpos = blk * DA_QBLOCK + jnp.arange(DA_QBLOCK)
        mask = kpos[None, :] <= qpos[:, None]
        p = jax.nn.softmax(jnp.where(mask, s, NEG), axis=-1)
        pd = p[:, :, 0] - lam_full * p[:, :, 1]
        return jnp.einsum('bhqk,bhkv->bhqv', pd.astype(v.dtype), v, preferred_element_type=jnp.float32)

    o = lax.map(attend, (qb, jnp.arange(nb)))
    o = o.transpose(1, 0, 3, 2, 4).reshape(B, S, H, dv)
    o = rmsnorm(o, subln_g) * (1.0 - lambda_init)
    o = o.reshape(B, S, DA_WIDTH) * jax.nn.silu(g.astype(jnp.float32))
    return o.astype(h.dtype) @ w_out


def sliding_window_attention(h, w_in, w_out, sinks, cos, sin):
    B, S, _ = h.shape
    d, KV, G, W = SW_HEAD_DIM, SW_KV_HEADS, SW_GROUP, WINDOW
    nkv = KV * d
    proj = h @ w_in
    q, k, v, g = jnp.split(proj, [SW_WIDTH, SW_WIDTH + nkv, SW_WIDTH + 2 * nkv], axis=-1)
    q = rope(q.reshape(B, S, SW_Q_HEADS, d), cos, sin) * (d ** -0.5)
    k = rope(k.reshape(B, S, KV, d), cos, sin)
    v = v.reshape(B, S, KV, d)
    nb = S // W
    qb = q.reshape(B, nb, W, KV, G, d)
    kb = k.reshape(B, nb, W, KV, d)
    vb = v.reshape(B, nb, W, KV, d)
    pad = ((0, 0), (1, 0), (0, 0), (0, 0), (0, 0))
    kk = jnp.concatenate([jnp.pad(kb, pad)[:, :-1], kb], axis=2)
    vv = jnp.concatenate([jnp.pad(vb, pad)[:, :-1], vb], axis=2)
    s = jnp.einsum('bnqhgd,bnkhd->bhgnqk', qb, kk, preferred_element_type=jnp.float32)
    qrel = jnp.arange(W)[:, None] + W
    krel = jnp.arange(2 * W)[None, :]
    band = (krel <= qrel) & (qrel - krel < W)
    has_prev = (jnp.arange(nb)[:, None, None] > 0) | (krel[None] >= W)
    mask = band[None] & has_prev
    s = jnp.where(mask[None, None, None], s, NEG)
    sk = sinks.astype(jnp.float32).reshape(KV, G)[None, :, :, None, None, None]
    m = jnp.maximum(jnp.max(s, axis=-1, keepdims=True), sk)
    e = jnp.exp(s - m)
    p = e / (jnp.sum(e, axis=-1, keepdims=True) + jnp.exp(sk - m))
    o = jnp.einsum('bhgnqk,bnkhd->bnqhgd', p.astype(vv.dtype), vv, preferred_element_type=jnp.float32)
    o = o.reshape(B, S, SW_WIDTH) * jax.nn.silu(g.astype(jnp.float32))
    return o.astype(h.dtype) @ w_out


def mlstm(h, w_in, b_gates, w_out, norm_g):
    B, S, _ = h.shape
    H, dk, dv, L = ML_HEADS, ML_QK_DIM, ML_V_DIM, ML_CHUNK
    nqk = H * dk
    proj = h @ w_in
    q, k, v, o, gif, g = jnp.split(
        proj, [nqk, 2 * nqk, 2 * nqk + ML_WIDTH, 2 * nqk + 2 * ML_WIDTH, 2 * nqk + 2 * ML_WIDTH + 2 * H], axis=-1)
    nc = S // L

    def chunks(t, dim):
        return t.reshape(B, nc, L, H, dim).transpose(1, 0, 3, 2, 4)

    qc = chunks(q * (dk ** -0.5), dk)
    kc = chunks(k, dk)
    vc = chunks(v, dv)
    gates = (gif.astype(jnp.float32) + b_gates.astype(jnp.float32)).reshape(B, S, 2, H)
    i_pre = gates[:, :, 0].reshape(B, nc, L, H).transpose(1, 0, 3, 2)
    log_f = jax.nn.log_sigmoid(gates[:, :, 1]).reshape(B, nc, L, H).transpose(1, 0, 3, 2)
    causal = jnp.tril(jnp.ones((L, L), dtype=bool))

    def step(carry, xs):
        C, n, m = carry
        qx, kx, vx, ix, fx = xs
        b = jnp.cumsum(fx, axis=-1)
        logw = jnp.where(causal, b[..., :, None] - b[..., None, :] + ix[..., None, :], NEG)
        log_inter = b + m[..., None]
        m_t = jnp.maximum(log_inter, jnp.max(logw, axis=-1))
        w_intra = jnp.exp(logw - m_t[..., None])
        w_inter = jnp.exp(log_inter - m_t)
        a = jnp.einsum('bhtd,bhsd->bhts', qx, kx, preferred_element_type=jnp.float32) * w_intra
        num = (jnp.einsum('bhts,bhsv->bhtv', a, vx)
               + w_inter[..., None] * jnp.einsum('bhvd,bhtd->bhtv', C, qx))
        den = jnp.sum(a, axis=-1) + w_inter * jnp.einsum('bhd,bhtd->bht', n, qx)
        hx = num / jnp.maximum(jnp.abs(den), jnp.exp(-m_t))[..., None]
        m_new = m_t[..., -1]
        wk = jnp.exp(b[..., -1:] - b + ix - m_new[..., None])
        decay = jnp.exp(b[..., -1] + m - m_new)
        C_new = decay[..., None, None] * C + jnp.einsum('bhs,bhsv,bhsd->bhvd', wk, vx, kx)
        n_new = decay[..., None] * n + jnp.einsum('bhs,bhsd->bhd', wk, kx)
        return (C_new, n_new, m_new), hx

    init = (jnp.zeros((B, H, dv, dk), jnp.float32), jnp.zeros((B, H, dk), jnp.float32),
            jnp.zeros((B, H), jnp.float32))
    _, hs = lax.scan(step, init, (qc, kc, vc, i_pre, log_f))
    hs = hs.transpose(1, 0, 3, 2, 4).reshape(B, S, H, dv)
    hs = rmsnorm(hs, norm_g).reshape(B, S, ML_WIDTH)
    out = hs * jax.nn.sigmoid(o.astype(jnp.float32)) * jax.nn.silu(g.astype(jnp.float32))
    return out.astype(h.dtype) @ w_out


def setup_inputs(seed: int = 0) -> dict:
    key = jax.random.key(seed)
    ks = jax.random.split(key, 16)
    f32 = jnp.float32
    nrm = lambda k, shape, s: jax.random.normal(k, shape, f32) * s
    x = jax.random.normal(ks[0], (BATCH, SEQ, D_MODEL), f32)
    positions = jnp.broadcast_to(jnp.arange(SEQ, dtype=jnp.int32), (BATCH, SEQ))
    norm_g = 1.0 + nrm(ks[1], (DEPTH, D_MODEL), 0.02)
    final_g = 1.0 + nrm(ks[2], (D_MODEL,), 0.02)
    da_w_in = nrm(ks[3], (N_A, D_MODEL, DA_IN), D_MODEL ** -0.5)
    da_w_out = nrm(ks[4], (N_A, DA_WIDTH, D_MODEL), DA_WIDTH ** -0.5)
    da_lambda = nrm(ks[5], (N_A, 4, DA_QK_DIM), 0.1)
    da_subln_g = 1.0 + nrm(ks[6], (N_A, DA_V_DIM), 0.02)
    sw_w_in = nrm(ks[7], (N_B, D_MODEL, SW_IN), D_MODEL ** -0.5)
    sw_w_out = nrm(ks[8], (N_B, SW_WIDTH, D_MODEL), SW_WIDTH ** -0.5)
    sw_sinks = nrm(ks[9], (N_B, SW_Q_HEADS), 0.5)
    ml_w_in = nrm(ks[10], (N_C, D_MODEL, ML_IN), D_MODEL ** -0.5)
    ib = nrm(ks[11], (N_C, ML_HEADS), 0.1)
    fb = 3.0 + nrm(ks[12], (N_C, ML_HEADS), 0.5)
    ml_b_gates = jnp.concatenate([ib, fb], axis=-1)
    ml_w_out = nrm(ks[13], (N_C, ML_WIDTH, D_MODEL), ML_WIDTH ** -0.5)
    ml_norm_g = 1.0 + nrm(ks[14], (N_C, ML_V_DIM), 0.02)
    return {"x": x, "positions": positions, "norm_g": norm_g, "final_g": final_g,
            "da_w_in": da_w_in, "da_w_out": da_w_out, "da_lambda": da_lambda, "da_subln_g": da_subln_g,
            "sw_w_in": sw_w_in, "sw_w_out": sw_w_out, "sw_sinks": sw_sinks,
            "ml_w_in": ml_w_in, "ml_b_gates": ml_b_gates, "ml_w_out": ml_w_out, "ml_norm_g": ml_norm_g}


def reference(x, positions, norm_g, final_g, da_w_in, da_w_out, da_lambda, da_subln_g,
              sw_w_in, sw_w_out, sw_sinks, ml_w_in, ml_b_gates, ml_w_out, ml_norm_g):
    cos_a, sin_a = rope_tables(positions, DA_QK_DIM)
    cos_b, sin_b = rope_tables(positions, SW_HEAD_DIM)
    for i in range(DEPTH):
        hn = rmsnorm(x, norm_g[i])
        kind, j = i % N_MIXERS, i // N_MIXERS
        if kind == 0:
            lambda_init = 0.8 - 0.6 * math.exp(-0.3 * i)
            y = diff_attention(hn, da_w_in[j], da_w_out[j], da_lambda[j], da_subln_g[j],
                               cos_a, sin_a, lambda_init)
        elif kind == 1:
            y = sliding_window_attention(hn, sw_w_in[j], sw_w_out[j], sw_sinks[j], cos_b, sin_b)
        else:
            y = mlstm(hn, ml_w_in[j], ml_b_gates[j], ml_w_out[j], ml_norm_g[j])
        x = x + y.astype(x.dtype)
    return rmsnorm(x, final_g)
```

```cpp
#include <hip/hip_runtime.h>
#include <hip/hip_cooperative_groups.h>
#include <cstdio>
#include <cstdint>
namespace cg = cooperative_groups;
#define LAS __attribute__((address_space(3)))
typedef unsigned short bf16_t;
typedef short bf16x8 __attribute__((ext_vector_type(8)));
typedef short s16x4 __attribute__((ext_vector_type(4)));
typedef float f32x4 __attribute__((ext_vector_type(4)));
typedef float f32x16 __attribute__((ext_vector_type(16)));
typedef unsigned u32x4 __attribute__((ext_vector_type(4)));
typedef unsigned u32x2 __attribute__((ext_vector_type(2)));
__device__ __forceinline__ unsigned cvtpk(float lo, float hi) { typedef float f2_t __attribute__((ext_vector_type(2))); typedef __bf16 b2_t __attribute__((ext_vector_type(2))); f2_t v = {lo, hi}; b2_t b = __builtin_convertvector(v, b2_t); return __builtin_bit_cast(unsigned, b); }
__device__ __forceinline__ float bf2f(unsigned short v) { return __uint_as_float(((unsigned)v) << 16); }
__device__ __forceinline__ float bflo(unsigned v) { return __uint_as_float(v << 16); }
__device__ __forceinline__ float bfhi(unsigned v) { return __uint_as_float(v & 0xffff0000u); }
constexpr float LOG2E = 1.4426950408889634f;
__device__ __forceinline__ float fsigmoid(float x) { return 1.0f / (1.0f + __expf(-x)); }
namespace pg8 {
#define PG8_LAS __attribute__((address_space(3)))
typedef unsigned short bf16_t;
typedef short bf16x8 __attribute__((ext_vector_type(8)));
typedef float f32x4 __attribute__((ext_vector_type(4)));
typedef unsigned u32x4 __attribute__((ext_vector_type(4)));
constexpr int BM = 256, BK = 64, HALF = 128, HTB = HALF * BK * 2  , STAGE_BYTES = 8 * HTB, NXCD = 8, WGM = 8;

__host__ __device__ __forceinline__ int lds_byte(int r, int c) { const int st = (r >> 4) * 2 + (c >> 5), rr = r & 15, cc = c & 31, ob = rr * 64 + cc * 2; return st * 1024 + (ob ^ (((ob >> 9) & 1) << 5)); }
__host__ __device__ __forceinline__ void stage_rc(int b, int& R, int& C) { const int st = b / 1024, sb = b % 1024, swz = sb ^ (((sb >> 9) & 1) << 5); R = (st >> 1) * 16 + swz / 64; C = (st & 1) * 32 + (swz % 64) / 2; }
__host__ __device__ __forceinline__ int perm32(int rho) { const int n = rho >> 4, i = rho & 15; return 8 * (i >> 2) + 4 * n + (i & 3); }

struct Unit { int pm, pn; };
struct Gemm { const bf16_t* A; const bf16_t* Bt; int M, N, K; };

struct StaticOrder {
    int nM, nN, nwg, G, c;
    __host__ __device__ void init(int M, int N, int G_, int c_) { nM = M / BM; nN = N / BM; nwg = nM * nN; G = G_; c = c_; }
    __host__ __device__ bool next(int i, Unit& u) const {
        const long L = (long)i * G + c; if (L >= nwg) return false;
        int wgid = (int)L; { const int q = nwg / NXCD, r = nwg % NXCD, xcd = wgid % NXCD, off = wgid / NXCD; wgid = (xcd < r ? xcd * (q + 1) : r * (q + 1) + (xcd - r) * q) + off; }
        const int nig = WGM * nN, gid = wgid / nig, fm = gid * WGM, gsz = (nM - fm) < WGM ? (nM - fm) : WGM;
        u.pm = fm + ((wgid % nig) % gsz); u.pn = (wgid % nig) / gsz; return true;
    }
    __device__ __forceinline__ void a_ready(const Unit&) const {}
    __device__ __forceinline__ void done(const Unit&) const {}
};

__device__ __forceinline__ void epi_plain(const f32x4 (&acc)[2][2][4][2], bf16_t* base, size_t stride, size_t ct0, size_t ct1, int act, float scale, int wr, int fr) {
    bf16_t* rowp = base + (size_t)(wr * 64 + fr) * stride;
#pragma unroll
    for (int ai = 0; ai < 2; ++ai)
#pragma unroll
        for (int m = 0; m < 4; ++m) {
#pragma unroll
            for (int bj = 0; bj < 2; ++bj) { f32x4 v0 = acc[ai][bj][m][0], v1 = acc[ai][bj][m][1];
                if (act == 0) { v0 = v0 * scale; v1 = v1 * scale; }
                else {
#pragma unroll
                    for (int j = 0; j < 4; ++j) { const float s0 = __builtin_amdgcn_rcpf(1.0f + __expf(-v0[j])), s1 = __builtin_amdgcn_rcpf(1.0f + __expf(-v1[j])); v0[j] = (act == 1) ? v0[j] * s0 : s0; v1[j] = (act == 1) ? v1[j] * s1 : s1; } }
                u32x4 w; w.x = ::cvtpk(v0[0], v0[1]); w.y = ::cvtpk(v0[2], v0[3]); w.z = ::cvtpk(v1[0], v1[1]); w.w = ::cvtpk(v1[2], v1[3]);
                *(u32x4*)(rowp + (bj ? ct1 : ct0)) = w; }
            rowp += (m == 3 ? (size_t)(HALF - 48) : (size_t)16) * stride;
            asm volatile("" : "+v"(rowp) :: "memory"); }
}
__device__ __forceinline__ void epi_rope(const f32x4 (&acc)[2][2][4][2], bf16_t* rowp, size_t adv_m, size_t adv_m1, size_t adv_ai, size_t half_off, const float* cp, const float* sp, int tstride, float scale) {
#pragma unroll
    for (int ai = 0; ai < 2; ++ai)
#pragma unroll
        for (int m = 0; m < 4; ++m) {
            { const f32x4 c0 = *(const f32x4*)(cp), c1 = *(const f32x4*)(cp + 4), s0 = *(const f32x4*)(sp), s1 = *(const f32x4*)(sp + 4);
              const f32x4 a0 = acc[ai][0][m][0], a1 = acc[ai][0][m][1], b0 = acc[ai][1][m][0], b1 = acc[ai][1][m][1];
              const f32x4 o10 = (a0 * c0 - b0 * s0) * scale, o11 = (a1 * c1 - b1 * s1) * scale, o20 = (b0 * c0 + a0 * s0) * scale, o21 = (b1 * c1 + a1 * s1) * scale;
              u32x4 w; w.x = ::cvtpk(o10[0], o10[1]); w.y = ::cvtpk(o10[2], o10[3]); w.z = ::cvtpk(o11[0], o11[1]); w.w = ::cvtpk(o11[2], o11[3]);
              *(u32x4*)rowp = w;
              w.x = ::cvtpk(o20[0], o20[1]); w.y = ::cvtpk(o20[2], o20[3]); w.z = ::cvtpk(o21[0], o21[1]); w.w = ::cvtpk(o21[2], o21[3]);
              *(u32x4*)(rowp + half_off) = w; }
            const size_t adv = (m == 3 ? (size_t)(HALF - 48) : (size_t)16);
            rowp += (m == 3 ? adv_ai : (m == 1 ? adv_m1 : adv_m)); cp += adv * tstride; sp += adv * tstride;
            asm volatile("" : "+v"(rowp), "+v"(cp), "+v"(sp) :: "memory"); }
}
constexpr size_t ACT_MiB = 1u << 20;
struct EpiProj {
    static constexpr bool PERM = true, AFTER_DRAIN = false;
    int kind; bf16_t* act; const float* cosT; const float* sinT; int skip;
    __device__ __forceinline__ void operator()(const f32x4 (&acc)[2][2][4][2], const Unit& u, int wr, int wc, int fr, int fq) const {
        if (skip) {
            f32x4 t = acc[0][0][0][0];
#pragma unroll
            for (int a = 0; a < 2; ++a)
#pragma unroll
                for (int b2 = 0; b2 < 2; ++b2)
#pragma unroll
                    for (int m = 0; m < 4; ++m)
#pragma unroll
                        for (int n = 0; n < 2; ++n) t += acc[a][b2][m][n];
            if (t[0] + t[1] + t[2] + t[3] == 12345.678f) act[0] = 1;
            return; }
        const int pn = u.pn, row0 = u.pm * BM, b = row0 >> 13, s0 = row0 & 8191;
        const size_t cp = (size_t)(wc * 32 + 8 * fq);
        bf16_t* G = act + 96 * ACT_MiB;
        const int rl0 = wr * 64 + fr;
        bool rope = false; bf16_t* base = G; size_t stride = 2048, ct0 = cp, ct1 = 128 + cp; int ac = 1; float scale = 1.0f;
        if (kind == 0) {
            if (pn < 16) {
                rope = true;
                const int h = pn & 7, isk = pn >> 3, map = wc >> 1, c1 = (wc & 1) * 32 + 8 * fq;
                const float* cpp = cosT + (size_t)(row0 + rl0) * 64 + c1; const float* spp = sinT + (size_t)(row0 + rl0) * 64 + c1;
                if (!isk) { bf16_t* q = act + ((size_t)((b * 8 + h) * 2 + map) * 8192 + s0 + rl0) * 128 + c1;
                    epi_rope(acc, q, 16 * 128, 16 * 128, (size_t)(HALF - 48) * 128, 64, cpp, spp, 64, 0.08838834764831845f * LOG2E); }
                else {
                    bf16_t* k = act + 32 * ACT_MiB + ((size_t)((b * 8 + h) * 2 + map) * 8192 + s0) * 128 + (size_t)(2 * wr) * 4096 + (size_t)(c1 >> 3) * 256 + (size_t)fr * 8;
                    epi_rope(acc, k, 128, 4096 - 128, (size_t)3 * 4096 - 128, 8 * 256, cpp, spp, 64, 1.0f); }
            } else if (pn < 24) { base = act + 64 * ACT_MiB + ((size_t)(b * 8 + (pn - 16)) * 8192 + s0) * 256; stride = 256; ac = 0; }
            else base = G + (size_t)row0 * 2048 + (pn - 24) * 256;
        } else if (kind == 1) {
            if (pn < 9) {
                rope = true;
                const int c1 = 8 * fq;
                bf16_t* bq = (pn < 8) ? act + ((size_t)(b * 32 + pn * 4 + wc) * 8192 + s0 + rl0) * 64 + c1 : act + 32 * ACT_MiB + ((size_t)(b * 4 + wc) * 8192 + s0 + rl0) * 64 + c1;
                epi_rope(acc, bq, 16 * 64, 16 * 64, (size_t)(HALF - 48) * 64, 32, cosT + (size_t)(row0 + rl0) * 32 + c1, sinT + (size_t)(row0 + rl0) * 32 + c1, 32, (pn < 8) ? 0.125f * LOG2E : 1.0f);
            } else if (pn == 9) {
                base = act + 36 * ACT_MiB + ((size_t)(b * 4) * 8192 + s0) * 64; stride = 64; ac = 0;
                ct0 = (size_t)(wc >> 1) * 8192 * 64 + (wc & 1) * 32 + 8 * fq; ct1 = ct0 + (size_t)2 * 8192 * 64;
            } else base = G + (size_t)row0 * 2048 + (pn - 10) * 256;
        } else {
            if (pn < 8) {
                base = act + ((pn < 4) ? 0 : 16 * ACT_MiB) + ((size_t)(b * 8) * 8192 + s0) * 128; stride = 128; ac = 0;
                ct0 = (size_t)(2 * (pn & 3)) * 8192 * 128 + cp; ct1 = ct0 + (size_t)8192 * 128; scale = (pn < 4) ? 0.08838834764831845f : 1.0f;
            } else if (pn < 16) { base = act + 32 * ACT_MiB + ((size_t)(b * 8 + (pn - 8)) * 8192 + s0) * 256; stride = 256; ac = 0; }
            else if (pn < 24) { base = act + 64 * ACT_MiB + (size_t)row0 * 2048 + (pn - 16) * 256; ac = 2; }
            else base = G + (size_t)row0 * 2048 + (pn - 24) * 256;
        }
        if (!rope) epi_plain(acc, base, stride, ct0, ct1, ac, scale, wr, fr);
    }
};
struct EpiRes {
    static constexpr bool PERM = false, AFTER_DRAIN = false;
    const float* xin; float* xout;
    __device__ __forceinline__ void operator()(const f32x4 (&acc)[2][2][4][2], const Unit& u, int wr, int wc, int fr, int fq) const {
        const int col0 = u.pn * BM + wc * 32 + 4 * fq;
#pragma unroll
        for (int ai = 0; ai < 2; ++ai)
#pragma unroll
            for (int m = 0; m < 4; ++m) { const size_t off = (size_t)(u.pm * BM + ai * HALF + wr * 64 + m * 16 + fr) * 2048 + col0;
#pragma unroll
                for (int bj = 0; bj < 2; ++bj)
#pragma unroll
                    for (int n = 0; n < 2; ++n) { const f32x4 bs = *(const f32x4*)(xin + off + bj * HALF + n * 16); *(f32x4*)(xout + off + bj * HALF + n * 16) = bs + acc[ai][bj][m][n]; }
                if (m & 1) asm volatile("" ::: "memory"); }
    }
};
template <class Epi, class Sched, bool ALIGN_EPI = false, bool SP2 = false>
__device__ __forceinline__ void gemm_phase(PG8_LAS unsigned char* lds, const Gemm g, const Sched& S, const Epi& E) {
    const int tid = threadIdx.x, wid = __builtin_amdgcn_readfirstlane(tid >> 6), lane = tid & 63, wr = wid >> 2, wc = wid & 3, fr = lane & 15, fq = lane >> 4;
    const int K = g.K, nt = K / BK;
    unsigned voffA[2], voffB[2];
#pragma unroll
    for (int i = 0; i < 2; ++i) { int R, C; stage_rc(tid * 16 + i * 8192, R, C); const int Rb = Epi::PERM ? ((R & ~31) + perm32(R & 31)) : R;
        voffA[i] = (unsigned)(R * K + C) * 2u; voffB[i] = (unsigned)(Rb * K + C) * 2u; }
    const size_t kstep = (size_t)(BK * 2);
    const size_t hstep = (size_t)HALF * K * 2;
    const size_t tstep = 2 * hstep;
    const unsigned ldsw = (unsigned)wid * 1024u;
    const int aoff = lds_byte(wr * 64 + fr, fq * 8), boff = lds_byte(wc * 32 + fr, fq * 8);
#define PG8_SA(b, h) (((b) * 2 + (h)) * HTB)
#define PG8_SB(b, h) ((4 + (b) * 2 + (h)) * HTB)
#define PG8_STAGE(bufoff, gbase, voff) do { _Pragma("unroll") for (int _i = 0; _i < 2; ++_i) \
        __builtin_amdgcn_global_load_lds((const unsigned*)((const char*)(gbase) + (voff)[_i]), (PG8_LAS unsigned*)(lds + (bufoff) + ldsw + _i * 8192), 16, 0, 0); } while (0)
#define PG8_LDA(dst, b, h) do { _Pragma("unroll") for (int m = 0; m < 4; ++m) _Pragma("unroll") for (int k = 0; k < 2; ++k) dst[m][k] = *(const PG8_LAS bf16x8*)(lds + PG8_SA(b, h) + aoff + m * 2048 + k * 1024); } while (0)
#define PG8_LDB(dst, b, h) do { _Pragma("unroll") for (int n = 0; n < 2; ++n) _Pragma("unroll") for (int k = 0; k < 2; ++k) dst[n][k] = *(const PG8_LAS bf16x8*)(lds + PG8_SB(b, h) + boff + n * 2048 + k * 1024); } while (0)
#define PG8_MMA(ai, bj, At, Bt) do { __builtin_amdgcn_s_setprio(1); _Pragma("unroll") for (int m = 0; m < 4; ++m) _Pragma("unroll") for (int n = 0; n < 2; ++n) _Pragma("unroll") for (int k = 0; k < 2; ++k) \
        acc[ai][bj][m][n] = __builtin_amdgcn_mfma_f32_16x16x32_bf16(Bt[n][k], At[m][k], acc[ai][bj][m][n], 0, 0, 0); __builtin_amdgcn_s_setprio(0); } while (0)
#define PG8_WAIT_V(n) asm volatile("s_waitcnt vmcnt(" #n ")" ::: "memory")
#define PG8_WAIT_L(n) asm volatile("s_waitcnt lgkmcnt(" #n ")" ::: "memory")
#define PG8_BAR __builtin_amdgcn_s_barrier()
#define PG8_SCHED __builtin_amdgcn_sched_barrier(0)
    Unit cur, nxt; int ui = 0;
    if (!S.next(0, cur)) return;
    f32x4 acc[2][2][4][2];
#pragma unroll
    for (int a = 0; a < 2; ++a)
#pragma unroll
        for (int b = 0; b < 2; ++b)
#pragma unroll
            for (int m = 0; m < 4; ++m)
#pragma unroll
                for (int n = 0; n < 2; ++n) acc[a][b][m][n] = (f32x4){0.f, 0.f, 0.f, 0.f};
    bf16x8 At[4][2], B0[2][2], B1[2][2];
    const char* cA = (const char*)g.A + (size_t)cur.pm * tstep; const char* cB = (const char*)g.Bt + (size_t)cur.pn * tstep;
    S.a_ready(cur);
    if constexpr (SP2) {
        PG8_STAGE(PG8_SB(0, 0), cB, voffB); PG8_STAGE(PG8_SB(0, 1), cB + hstep, voffB); PG8_STAGE(PG8_SA(0, 0), cA, voffA); PG8_STAGE(PG8_SA(0, 1), cA + hstep, voffA);
        if (wr == 1) PG8_BAR;
        PG8_WAIT_V(2); PG8_BAR;
        PG8_STAGE(PG8_SB(1, 0), cB + kstep, voffB); PG8_STAGE(PG8_SA(1, 0), cA + kstep, voffA); PG8_STAGE(PG8_SB(1, 1), cB + hstep + kstep, voffB);
        PG8_WAIT_V(6); PG8_BAR;
    } else {
        PG8_STAGE(PG8_SB(0, 0), cB, voffB); PG8_STAGE(PG8_SA(0, 0), cA, voffA); PG8_STAGE(PG8_SB(0, 1), cB + hstep, voffB); PG8_STAGE(PG8_SA(0, 1), cA + hstep, voffA);
        if (wr == 1) PG8_BAR;
        PG8_WAIT_V(4); PG8_BAR;
        PG8_STAGE(PG8_SB(1, 0), cB + kstep, voffB); PG8_STAGE(PG8_SA(1, 0), cA + kstep, voffA); PG8_STAGE(PG8_SB(1, 1), cB + hstep + kstep, voffB);
        PG8_WAIT_V(6); PG8_BAR;
    }
    for (;;) {
        const bool has_next = S.next(ui + 1, nxt);
        const char* nA = has_next ? (const char*)g.A + (size_t)nxt.pm * tstep : cA; const char* nB = has_next ? (const char*)g.Bt + (size_t)nxt.pn * tstep : cB;
        for (int t = 0; t < nt; t += 2) {
            const bool last = (t == nt - 2);
            const char* a1 = cA + (size_t)(t + 1) * kstep;
            const char* a2 = last ? nA : cA + (size_t)(t + 2) * kstep; const char* b2 = last ? nB : cB + (size_t)(t + 2) * kstep;
            const char* a3 = a2 + kstep; const char* b3 = b2 + kstep;
            if (last && has_next) S.a_ready(nxt);
            if constexpr (SP2) {
            PG8_LDB(B0, 0, 0); PG8_LDB(B1, 0, 1); PG8_SCHED; PG8_LDA(At, 0, 0); PG8_STAGE(PG8_SA(1, 1), a1 + hstep, voffA);
            PG8_WAIT_V(8); PG8_WAIT_L(0); PG8_BAR; PG8_MMA(0, 0, At, B0); PG8_MMA(0, 1, At, B1); PG8_BAR; PG8_SCHED;
            PG8_LDA(At, 0, 1); PG8_STAGE(PG8_SB(0, 0), b2, voffB); PG8_STAGE(PG8_SB(0, 1), b2 + hstep, voffB); PG8_STAGE(PG8_SA(0, 0), a2, voffA);
            PG8_WAIT_V(8); PG8_WAIT_L(0); PG8_BAR; PG8_MMA(1, 0, At, B0); PG8_MMA(1, 1, At, B1); PG8_BAR; PG8_SCHED;
            PG8_LDB(B0, 1, 0); PG8_LDB(B1, 1, 1); PG8_SCHED; PG8_LDA(At, 1, 0); PG8_STAGE(PG8_SA(0, 1), a2 + hstep, voffA);
            PG8_WAIT_V(8); PG8_WAIT_L(0); PG8_BAR; PG8_MMA(0, 0, At, B0); PG8_MMA(0, 1, At, B1); PG8_BAR; PG8_SCHED;
            PG8_LDA(At, 1, 1); PG8_STAGE(PG8_SB(1, 0), b3, voffB); PG8_STAGE(PG8_SB(1, 1), b3 + hstep, voffB); PG8_STAGE(PG8_SA(1, 0), a3, voffA);
            PG8_WAIT_V(8); PG8_WAIT_L(0); PG8_BAR; PG8_MMA(1, 0, At, B0); PG8_MMA(1, 1, At, B1); PG8_BAR; PG8_SCHED;
            } else {
            PG8_LDB(B0, 0, 0); PG8_SCHED; PG8_LDA(At, 0, 0); PG8_STAGE(PG8_SA(1, 1), a1 + hstep, voffA);
            PG8_WAIT_L(8); PG8_BAR; PG8_WAIT_L(0); PG8_MMA(0, 0, At, B0); PG8_BAR; PG8_SCHED;
            PG8_LDB(B1, 0, 1); PG8_STAGE(PG8_SB(0, 0), b2, voffB);
            PG8_BAR; PG8_WAIT_L(0); PG8_MMA(0, 1, At, B1); PG8_BAR;
            PG8_LDA(At, 0, 1); PG8_STAGE(PG8_SA(0, 0), a2, voffA);
            PG8_BAR; PG8_WAIT_L(0); PG8_MMA(1, 0, At, B0); PG8_BAR; PG8_SCHED;
            PG8_STAGE(PG8_SB(0, 1), b2 + hstep, voffB);
            PG8_WAIT_V(6); PG8_BAR; PG8_MMA(1, 1, At, B1); PG8_BAR;
            PG8_LDB(B0, 1, 0); PG8_SCHED; PG8_LDA(At, 1, 0); PG8_STAGE(PG8_SA(0, 1), a2 + hstep, voffA);
            PG8_WAIT_L(8); PG8_BAR; PG8_WAIT_L(0); PG8_MMA(0, 0, At, B0); PG8_BAR; PG8_SCHED;
            PG8_LDB(B1, 1, 1); PG8_STAGE(PG8_SB(1, 0), b3, voffB);
            PG8_BAR; PG8_WAIT_L(0); PG8_MMA(0, 1, At, B1); PG8_BAR;
            PG8_LDA(At, 1, 1); PG8_STAGE(PG8_SA(1, 0), a3, voffA);
            PG8_BAR; PG8_WAIT_L(0); PG8_MMA(1, 0, At, B0); PG8_BAR; PG8_SCHED;
            PG8_STAGE(PG8_SB(1, 1), b3 + hstep, voffB);
            PG8_WAIT_V(6); PG8_BAR; PG8_MMA(1, 1, At, B1); PG8_BAR;
            }
        }
        if constexpr (ALIGN_EPI) { if (wr == 0) PG8_BAR; }
        if constexpr (!Epi::AFTER_DRAIN) { E(acc, cur, wr, wc, fr, fq); S.done(cur); }
        if (!has_next) break;
#pragma unroll
        for (int a = 0; a < 2; ++a)
#pragma unroll
            for (int b = 0; b < 2; ++b)
#pragma unroll
                for (int m = 0; m < 4; ++m)
#pragma unroll
                    for (int n = 0; n < 2; ++n) acc[a][b][m][n] = (f32x4){0.f, 0.f, 0.f, 0.f};
        cur = nxt; cA = nA; cB = nB; ++ui;
        if constexpr (ALIGN_EPI) { if (wr == 1) PG8_BAR; }
    }
    PG8_WAIT_V(0);
    if constexpr (!ALIGN_EPI) { if (wr == 0) PG8_BAR; }
    PG8_BAR;
    if constexpr (Epi::AFTER_DRAIN) { E.fused(acc, cur, wr, wc, fr, fq, lds, wid, lane); S.done(cur); }
#undef PG8_SA
#undef PG8_SB
#undef PG8_STAGE
#undef PG8_LDA
#undef PG8_LDB
#undef PG8_MMA
#undef PG8_WAIT_V
#undef PG8_WAIT_L
#undef PG8_BAR
#undef PG8_SCHED
}
}

constexpr int TOK = 16384, DM = 2048, SEQL = 8192;
constexpr size_t MiB = 1u << 20;
constexpr size_t WS_ROPEA_C = 1 * MiB, WS_ROPEA_S = 5 * MiB, WS_ROPEB_C = 9 * MiB, WS_ROPEB_S = 11 * MiB, WS_GIF = 13 * MiB, WS_SCAN = 14 * MiB;
constexpr size_t WS_W_DA0_IN = 16 * MiB, WS_W_DA0_OUT = 48 * MiB, WS_W_SW_IN = 56 * MiB, WS_W_SW_OUT = 74 * MiB, WS_W_ML_IN = 82 * MiB, WS_W_ML_OUT = 114 * MiB, WS_W_DA1_IN = 122 * MiB, WS_W_DA1_OUT = 154 * MiB;
constexpr size_t WS_HN = 162 * MiB, WS_ACT = 226 * MiB, WS_END = 482 * MiB;
constexpr size_t WS_MLSTATE = 16 * MiB;
constexpr size_t WS_MLN = 48 * MiB;
constexpr int SC_BL = 0, SC_II = 131072, SC_MT = 262144, SC_MC = 393216, SC_SD = 393216 + 4096;
constexpr int LDS_BYTES = 147456, RING_BYTES = 131072, MISC_OFF = 131072;
constexpr int NWAVES = 8;

__device__ __forceinline__ float wave_sum(float v) {
#pragma unroll
    for (int o = 1; o < 64; o <<= 1) v += __shfl_xor(v, o);
    return v;
}
__device__ __forceinline__ int crow(int r, int hi) { return (r & 3) + 8 * (r >> 2) + 4 * hi; }
__device__ __forceinline__ bf16x8 pack8(float a0, float a1, float a2, float a3, float a4, float a5, float a6, float a7) {
    u32x4 w; w.x = cvtpk(a0, a1); w.y = cvtpk(a2, a3); w.z = cvtpk(a4, a5); w.w = cvtpk(a6, a7); return __builtin_bit_cast(bf16x8, w);
}
__device__ __forceinline__ bf16x8 cat4(s16x4 lo, s16x4 hi) { return (bf16x8){lo[0], lo[1], lo[2], lo[3], hi[0], hi[1], hi[2], hi[3]}; }
typedef short v4i16_t __attribute__((ext_vector_type(4)));
__device__ __forceinline__ s16x4 trrd(const LAS unsigned char* p) { return __builtin_bit_cast(s16x4, __builtin_amdgcn_ds_read_tr16_b64_v4i16((LAS v4i16_t*)p)); }
#define MFMA32(a, b, c) __builtin_amdgcn_mfma_f32_32x32x16_bf16((a), (b), (c), 0, 0, 0)
__device__ __forceinline__ int off256(int row, int ch) { return row * 256 + ((ch ^ (row & 15)) << 4); }
__device__ __forceinline__ int off512(int row, int ch) { return row * 512 + ((ch ^ ((row & 3) << 2)) << 4); }
__device__ __forceinline__ int off128k(int row, int ch) { return row * 128 + ((ch ^ (row & 7)) << 4); }
__device__ __forceinline__ int off128v(int row, int ch) { return row * 128 + ((ch ^ (((row >> 1) & 1) << 2)) << 4); }

__device__ __forceinline__ void transpose_item(const float* W, int K, int Nsrc, bf16_t* WT, int n_phys0, int n_src0, int k0, LAS float* scr, int lane) {
#pragma unroll 8
    for (int i = 0; i < 32; ++i) { const int kk = 2 * i + (lane >> 5); scr[kk * 33 + (lane & 31)] = W[(size_t)(k0 + kk) * Nsrc + n_src0 + (lane & 31)]; }
    asm volatile("s_waitcnt lgkmcnt(0)" ::: "memory");
    const int c = lane & 7;
#pragma unroll
    for (int j = 0; j < 4; ++j) { const int n = (lane >> 3) + 8 * j; const LAS float* s = scr + (8 * c) * 33 + n;
        u32x4 o; o.x = cvtpk(s[0 * 33], s[1 * 33]); o.y = cvtpk(s[2 * 33], s[3 * 33]); o.z = cvtpk(s[4 * 33], s[5 * 33]); o.w = cvtpk(s[6 * 33], s[7 * 33]);
        *(u32x4*)(WT + (size_t)(n_phys0 + n) * K + k0 + 8 * c) = o; }
    asm volatile("s_waitcnt lgkmcnt(0)" ::: "memory");
}
__device__ __forceinline__ int src_col(int mode, int nb) {
    const int tile = nb >> 3, g = nb & 7, bj = g >> 2, wc = g & 3;
    if (mode == 1 && tile < 16) return tile * 256 + (wc >> 1) * 128 + ((wc & 1) + 2 * bj) * 32;
    if (mode == 2 && tile < 9) return tile * 256 + wc * 64 + bj * 32;
    int p = nb * 32;
    if (mode == 3 && p >= 6144) p += 16;
    return p;
}
struct CvMat { const float* W; bf16_t* WT; int Nsrc, Nphys, mode; };
__device__ __forceinline__ void cv_load(const CvMat& m, int item, int lane, f32x4 (&v)[16]) {
    const int nblk = m.Nphys / 64, kb = item / nblk, nb2 = item % nblk, k0 = kb * 64;
    const int col4 = (lane & 15) * 4, src = ((col4 >> 5) ? src_col(m.mode, 2 * nb2 + 1) : src_col(m.mode, 2 * nb2)) + (col4 & 31);
    const float* p = m.W + (size_t)(k0 + (lane >> 4)) * m.Nsrc + src;
#pragma unroll
    for (int i = 0; i < 16; ++i) v[i] = *(const f32x4*)(p + (size_t)(4 * i) * m.Nsrc);
}
__device__ __forceinline__ void cv_store(const CvMat& m, int item, int lane, const f32x4 (&v)[16], LAS float* scr) {
    const int nblk = m.Nphys / 64, kb = item / nblk, nb2 = item % nblk, k0 = kb * 64, n_phys0 = nb2 * 64, col4 = (lane & 15) * 4;
#pragma unroll
    for (int i = 0; i < 16; ++i) { LAS float* d = scr + (4 * i + (lane >> 4)) * 65 + col4; d[0] = v[i].x; d[1] = v[i].y; d[2] = v[i].z; d[3] = v[i].w; }
    asm volatile("s_waitcnt lgkmcnt(0)" ::: "memory");
    const int c = lane & 7;
#pragma unroll
    for (int j = 0; j < 8; ++j) { const int n = (lane >> 3) + 8 * j; const LAS float* sp = scr + (8 * c) * 65 + n;
        u32x4 o; o.x = cvtpk(sp[0 * 65], sp[1 * 65]); o.y = cvtpk(sp[2 * 65], sp[3 * 65]); o.z = cvtpk(sp[4 * 65], sp[5 * 65]); o.w = cvtpk(sp[6 * 65], sp[7 * 65]);
        *(u32x4*)(m.WT + (size_t)(n_phys0 + n) * 2048 + k0 + 8 * c) = o; }
    asm volatile("s_waitcnt lgkmcnt(0)" ::: "memory");
}
__device__ __forceinline__ void cv_decode(const CvMat& a, const CvMat& b, const CvMat& c, const CvMat& d, int na, int nb, int nc, int it, CvMat& m, int& r) {
    r = it; m = a;
    if (r >= na) { r -= na; m = b; if (r >= nb) { r -= nb; m = c; if (r >= nc) { r -= nc; m = d; } } }
}
__device__ __forceinline__ void convert_set(const CvMat& a, const CvMat& b, const CvMat& c, const CvMat& d, int na, int nb, int nc, int nd, int first, int step, LAS float* scr, int lane) {
    const int total = na + nb + nc + nd;
    if (first >= total) return;
    f32x4 v[16], vn[16]; CvMat m, mn; int r, rn;
    cv_decode(a, b, c, d, na, nb, nc, first, m, r); cv_load(m, r, lane, v);
    for (int it = first; it < total; it += step) {
        const bool more = it + step < total;
        if (more) { cv_decode(a, b, c, d, na, nb, nc, it + step, mn, rn); cv_load(mn, rn, lane, vn); }
        cv_store(m, r, lane, v, scr);
        if (more) { m = mn; r = rn;
#pragma unroll
            for (int i = 0; i < 16; ++i) v[i] = vn[i]; }
    }
}
template <bool GIF> __device__ __forceinline__ void norm_rows(const float* xin, const float* g, bf16_t* hn, int gw, int NGW, int lane, const LAS float* wg, const float* bg, float* gif) {
    for (int row = gw; row < TOK; row += NGW) {
        const f32x4* xr = (const f32x4*)(xin + (size_t)row * DM) + lane;
        f32x4 v[8]; float s = 0.f;
#pragma unroll
        for (int j = 0; j < 8; ++j) { v[j] = xr[64 * j]; s += (v[j].x * v[j].x + v[j].y * v[j].y) + (v[j].z * v[j].z + v[j].w * v[j].w); }
        const float r = 1.0f / sqrtf(wave_sum(s) * (1.0f / DM) + 1e-6f);
        u32x2* o8 = (u32x2*)(hn + (size_t)row * DM) + lane;
#pragma unroll
        for (int j = 0; j < 8; ++j) { const f32x4 gv = ((const f32x4*)g)[64 * j + lane]; v[j] = v[j] * r * gv; u32x2 w; w.x = cvtpk(v[j].x, v[j].y); w.y = cvtpk(v[j].z, v[j].w); o8[64 * j] = w; }
        if (GIF) {
            float mine = 0.f;
#pragma unroll 1
            for (int jj = 0; jj < 16; ++jj) { float p = 0.f;
#pragma unroll
                for (int j = 0; j < 8; ++j) { const f32x4 w = *(const LAS f32x4*)(wg + jj * 2048 + 256 * j + 4 * lane); p += (v[j].x * w.x + v[j].y * w.y) + (v[j].z * w.z + v[j].w * w.w); }
                p = wave_sum(p); if (lane == jj) mine = p; }
            if (lane < 16) gif[(size_t)row * 16 + lane] = mine + bg[lane];
        }
    }
}

constexpr int SC_BLC = 393216 + 8192, SC_CML = 393216 + 12288;
__device__ __forceinline__ void norm_gif_chunk(const float* xin, const float* g, bf16_t* hn, const LAS float* wg, LAS float* gl, const float* bg, float* sc, int cidx, int wave, int lane) {
    for (int i = 0; i < 8; ++i) {
        const int rl = wave * 8 + i, row = cidx * 64 + rl;
        const f32x4* xr = (const f32x4*)(xin + (size_t)row * DM) + lane;
        f32x4 v[8]; float s = 0.f;
#pragma unroll
        for (int j = 0; j < 8; ++j) { v[j] = xr[64 * j]; s += (v[j].x * v[j].x + v[j].y * v[j].y) + (v[j].z * v[j].z + v[j].w * v[j].w); }
        const float r = 1.0f / sqrtf(wave_sum(s) * (1.0f / DM) + 1e-6f);
        u32x2* o8 = (u32x2*)(hn + (size_t)row * DM) + lane;
#pragma unroll
        for (int j = 0; j < 8; ++j) { const f32x4 gv = ((const f32x4*)g)[64 * j + lane]; v[j] = v[j] * r * gv; u32x2 w; w.x = cvtpk(v[j].x, v[j].y); w.y = cvtpk(v[j].z, v[j].w); o8[64 * j] = w; }
        float mine = 0.f;
#pragma unroll 1
        for (int jj = 0; jj < 16; ++jj) { float p = 0.f;
#pragma unroll
            for (int j = 0; j < 8; ++j) { const f32x4 w = *(const LAS f32x4*)(wg + jj * 2048 + 256 * j + 4 * lane); p += (v[j].x * w.x + v[j].y * w.y) + (v[j].z * w.z + v[j].w * w.w); }
            p = wave_sum(p); if (lane == jj) mine = p; }
        if (lane < 16) gl[rl * 16 + lane] = mine + bg[lane];
    }
    __syncthreads();
    { const int h = wave, b = cidx >> 7, c = cidx & 127, bh = b * 8 + h, t = 64 * c + lane;
      const float ip = gl[lane * 16 + h], fp = gl[lane * 16 + 8 + h];
      const float lf = fminf(fp, 0.f) - log1pf(expf(-fabsf(fp)));
      float bs = lf;
#pragma unroll
      for (int o = 1; o < 64; o <<= 1) { const float vv = __shfl_up(bs, o); if (lane >= o) bs += vv; }
      float cm = ip - bs;
#pragma unroll
      for (int o = 1; o < 64; o <<= 1) { const float vv = __shfl_up(cm, o); if (lane >= o) cm = fmaxf(cm, vv); }
      sc[SC_BL + bh * 8192 + t] = bs; sc[SC_II + bh * 8192 + t] = ip; sc[SC_MT + bh * 8192 + t] = cm;
      if (lane == 63) { sc[SC_BLC + bh * 128 + c] = bs; sc[SC_CML + bh * 128 + c] = cm; } }
    __syncthreads();
}
__device__ __forceinline__ void final_norm_rows(float* x, const float* g, int gw, int NGW, int lane) {
    for (int row = gw; row < TOK; row += NGW) {
        f32x4* xr = (f32x4*)(x + (size_t)row * DM) + lane;
        f32x4 v[8]; float s = 0.f;
#pragma unroll
        for (int j = 0; j < 8; ++j) { v[j] = xr[64 * j]; s += (v[j].x * v[j].x + v[j].y * v[j].y) + (v[j].z * v[j].z + v[j].w * v[j].w); }
        const float r = 1.0f / sqrtf(wave_sum(s) * (1.0f / DM) + 1e-6f);
#pragma unroll
        for (int j = 0; j < 8; ++j) { const f32x4 gv = ((const f32x4*)g)[64 * j + lane]; xr[64 * j] = v[j] * r * gv; }
    }
}
__device__ __forceinline__ void rope_table(const int* pos, int nf, float* ct, float* st, int gtid, int ngt) {
    for (int i = gtid; i < TOK * nf; i += ngt) {
        const int tokn = i / nf, f = i - tokn * nf;
        const float invf = (float)exp2(-(double)f / (double)nf * 13.287712379549449);
        const float ang = (float)pos[tokn] * invf;
        double rv = (double)ang * 0.15915494309189535; rv -= floor(rv);
        const float rf = (float)rv;
        ct[i] = __builtin_amdgcn_cosf(rf); st[i] = __builtin_amdgcn_sinf(rf);
    }
}

namespace da {
constexpr int KSLOT = 16384, VBASE = 49152, VSLOT = 16384;
__device__ __forceinline__ void glds16(const void* gsrc, unsigned lds_dst) { unsigned keep;
    asm volatile("s_mov_b32 %0, m0\n\ts_mov_b32 m0, %2\n\ts_nop 0\n\tglobal_load_lds_dwordx4 %1, off\n\ts_mov_b32 m0, %0" : "=&s"(keep) : "v"(gsrc), "s"(lds_dst) : "memory"); }
__device__ __forceinline__ void issue_k(LAS unsigned char* lds, int slot, const bf16_t* K0, const bf16_t* K1, int t, int wid, int lane) {
    const unsigned d = (unsigned)(uintptr_t)(lds + slot * KSLOT + wid * 1024);
    glds16(K0 + (size_t)t * 4096 + (size_t)(wid * 64 + lane) * 8, (unsigned)__builtin_amdgcn_readfirstlane((int)d));
    glds16(K1 + (size_t)t * 4096 + (size_t)(wid * 64 + lane) * 8, (unsigned)__builtin_amdgcn_readfirstlane((int)(d + 8192u)));
}
__device__ __forceinline__ void issue_v(LAS unsigned char* lds, int slot, const bf16_t* V, int t, int wid, int lane) {
#pragma unroll
    for (int ii = 0; ii < 2; ++ii) { const int i = 2 * wid + ii, row = 2 * i + (lane >> 5), chp = lane & 31;
        const bf16_t* src = V + (size_t)(t * 32 + row) * 256 + ((chp ^ ((row & 3) << 2)) << 3);
        glds16(src, (unsigned)__builtin_amdgcn_readfirstlane((int)(unsigned)(uintptr_t)(lds + VBASE + slot * VSLOT + i * 1024))); }
}
#define DA_VADDR(i) (vq + (vb0 ^ (((i) & 3) << 6)) + ((((i) & 7) >> 2) * 256) + (16 * ((i) >> 3)) * 512)
__device__ __forceinline__ void pv_plain(f32x16 (&O)[8], const LAS unsigned char* vq, int vb0, bf16x8 pa0, bf16x8 pa1) {
    s16x4 vl[4], vh[4];
#pragma unroll
    for (int i = 0; i < 3; ++i) { vl[i] = trrd(DA_VADDR(i)); vh[i] = trrd(DA_VADDR(i) + 4096); }
    __builtin_amdgcn_sched_barrier(0);
#pragma unroll
    for (int i = 0; i < 16; ++i) {
        if (i + 3 < 16) { vl[(i + 3) & 3] = trrd(DA_VADDR(i + 3)); vh[(i + 3) & 3] = trrd(DA_VADDR(i + 3) + 4096); }
        O[i & 7] = MFMA32(i < 8 ? pa0 : pa1, cat4(vl[i & 3], vh[i & 3]), O[i & 7]);
        __builtin_amdgcn_sched_barrier(0);
    }
}
template <int VAR> __device__ __forceinline__ void unit(LAS unsigned char* lds, LAS float* wscr, const bf16_t* Q, const bf16_t* K, const bf16_t* V, const bf16_t* G, bf16_t* AO, const float* subg, float lam, float osc, int b, int h, int qb) {
    const int tid = threadIdx.x, lane = tid & 63, wid = __builtin_amdgcn_readfirstlane(tid >> 6), g = wid & 3, map = wid >> 2, r32 = lane & 31, hi = lane >> 5;
    const int q4 = (lane & 15) >> 2, p4 = lane & 3, blk = (lane >> 4) & 1;
    const bf16_t* K0 = K + (size_t)((b * 8 + h) * 2) * 8192 * 128; const bf16_t* K1 = K0 + (size_t)8192 * 128;
    const bf16_t* Vb = V + (size_t)(b * 8 + h) * 8192 * 256;
    const int qrow0 = qb * 128 + g * 32;
    const bf16_t* Qw = Q + ((size_t)((b * 8 + h) * 2 + map) * 8192 + qrow0) * 128;
    const int NT = 4 * qb + 4;
    issue_k(lds, 0, K0, K1, 0, wid, lane); issue_v(lds, 0, Vb, 0, wid, lane); issue_k(lds, 1, K0, K1, 1, wid, lane);
    bf16x8 qf[8];
#pragma unroll
    for (int d0 = 0; d0 < 8; ++d0) qf[d0] = *(const bf16x8*)(Qw + (size_t)r32 * 128 + d0 * 16 + hi * 8);
    f32x16 O[8];
#pragma unroll
    for (int n = 0; n < 8; ++n)
#pragma unroll
        for (int r = 0; r < 16; ++r) O[n][r] = 0.f;
    float mhat = -1e30f, lsum = 0.f;
    const int qabs = qrow0 + r32;
    const int vb0 = (4 * hi + q4) * 512 + (((4 * q4) + 2 * blk + (p4 >> 1)) << 4) + 8 * (p4 & 1);
    bf16x8 pa0, pa1;
#pragma unroll
    for (int j = 0; j < 8; ++j) { pa0[j] = 0; pa1[j] = 0; }
    int sl = 0, slp = 2;
    for (int t = 0; t < NT; ++t) {
        if (t + 2 < NT) asm volatile("s_waitcnt vmcnt(4)\n\ts_barrier" ::: "memory"); else asm volatile("s_waitcnt vmcnt(0)\n\ts_barrier" ::: "memory");
        if (t + 2 < NT) issue_k(lds, slp, K0, K1, t + 2, wid, lane);
        if (t + 1 < NT) issue_v(lds, (sl == 2 ? 0 : sl + 1), Vb, t + 1, wid, lane);
        if (VAR == 6) { slp = sl; sl = (sl == 2 ? 0 : sl + 1); continue; }
        const LAS unsigned char* kp = lds + sl * KSLOT + map * 8192 + hi * 512 + r32 * 16;
        const LAS unsigned char* vq = lds + VBASE + slp * VSLOT;
        f32x16 sc;
#pragma unroll
        for (int r = 0; r < 16; ++r) sc[r] = 0.f;
        { bf16x8 kf[2];
          kf[0] = *(const LAS bf16x8*)(kp);
          __builtin_amdgcn_sched_barrier(0);
#pragma unroll
          for (int d0 = 0; d0 < 8; ++d0) {
              if (d0 + 1 < 8) kf[(d0 + 1) & 1] = *(const LAS bf16x8*)(kp + (d0 + 1) * 1024);
              __builtin_amdgcn_s_setprio(1);
              sc = MFMA32(kf[d0 & 1], qf[d0], sc);
              __builtin_amdgcn_s_setprio(0);
              __builtin_amdgcn_sched_barrier(0); } }
        if (t >= 4 * qb) {
#pragma unroll
            for (int r = 0; r < 16; ++r) { const int kv = 32 * t + crow(r, hi); if (kv > qabs) sc[r] = -1e30f; }
        }
        float mx = fmaxf(fmaxf(sc[0], sc[1]), fmaxf(sc[2], sc[3]));
#pragma unroll
        for (int r = 4; r < 16; r += 4) mx = fmaxf(mx, fmaxf(fmaxf(sc[r], sc[r + 1]), fmaxf(sc[r + 2], sc[r + 3])));
        { auto rr = __builtin_amdgcn_permlane32_swap(__float_as_uint(mx), __float_as_uint(mx), false, false); mx = fmaxf(__uint_as_float(rr[0]), __uint_as_float(rr[1])); }
        float ls = 0.f;
        const bool resc = __any(mx > mhat + 8.0f);
        const float mnew = resc ? fmaxf(mhat, mx) : mhat, alpha = __builtin_amdgcn_exp2f(mhat - mnew);
        mhat = mnew;
        if (t == 0) {
#pragma unroll
            for (int r = 0; r < 16; ++r) { sc[r] = __builtin_amdgcn_exp2f(sc[r] - mhat); ls += sc[r]; }
        } else {
            s16x4 vl[2], vh[2];
            vl[0] = trrd(DA_VADDR(0)); vh[0] = trrd(DA_VADDR(0) + 4096);
            __builtin_amdgcn_sched_barrier(0);
#pragma unroll
            for (int i = 0; i < 16; ++i) {
                if (i + 1 < 16) { vl[(i + 1) & 1] = trrd(DA_VADDR(i + 1)); vh[(i + 1) & 1] = trrd(DA_VADDR(i + 1) + 4096); }
                __builtin_amdgcn_s_setprio(1);
                if (VAR != 2) O[i & 7] = MFMA32(i < 8 ? pa0 : pa1, cat4(vl[i & 1], vh[i & 1]), O[i & 7]);
                __builtin_amdgcn_s_setprio(0);
                sc[i] = __builtin_amdgcn_exp2f(sc[i] - mhat); ls += sc[i];
                __builtin_amdgcn_sched_barrier(0);
            }
        }
        if (resc) {
            wscr[r32] = alpha;
#pragma unroll
            for (int gq = 0; gq < 4; ++gq) { const f32x4 a4 = *(const LAS f32x4*)(wscr + 8 * gq + 4 * hi);
#pragma unroll
                for (int n = 0; n < 8; ++n)
#pragma unroll
                    for (int e = 0; e < 4; ++e) O[n][4 * gq + e] *= a4[e]; }
        }
        lsum *= alpha;
        lsum += ls;
        pa0 = pack8(sc[0], sc[1], sc[2], sc[3], sc[4], sc[5], sc[6], sc[7]); pa1 = pack8(sc[8], sc[9], sc[10], sc[11], sc[12], sc[13], sc[14], sc[15]);
        slp = sl; sl = (sl == 2 ? 0 : sl + 1);
    }
    pv_plain(O, lds + VBASE + slp * VSLOT, vb0, pa0, pa1);
    lsum += __shfl_xor(lsum, 32);
    { const float f = (map == 0 ? 1.0f : lam) / lsum;
      wscr[r32] = f;
#pragma unroll
      for (int gq = 0; gq < 4; ++gq) { const f32x4 a4 = *(const LAS f32x4*)(wscr + 8 * gq + 4 * hi);
#pragma unroll
          for (int n = 0; n < 8; ++n)
#pragma unroll
              for (int e = 0; e < 4; ++e) O[n][4 * gq + e] *= a4[e]; } }
    __syncthreads();
    LAS float* xch = (LAS float*)(lds + g * 32768);
    if (map == 1) {
#pragma unroll
        for (int n = 0; n < 8; ++n)
#pragma unroll
            for (int r = 0; r < 16; ++r) xch[(n * 16 + r) * 64 + lane] = O[n][r];
    }
    __syncthreads();
    if (map == 0 && (VAR == 0 || lsum == 12345.678f)) {
        float ssq[16];
#pragma unroll
        for (int r = 0; r < 16; ++r) ssq[r] = 0.f;
#pragma unroll
        for (int n = 0; n < 8; ++n)
#pragma unroll
            for (int r = 0; r < 16; ++r) { O[n][r] -= xch[(n * 16 + r) * 64 + lane]; ssq[r] += O[n][r] * O[n][r]; }
#pragma unroll
        for (int r = 0; r < 16; ++r) {
#pragma unroll
            for (int o = 1; o < 32; o <<= 1) ssq[r] += __shfl_xor(ssq[r], o);
            ssq[r] = osc / sqrtf(ssq[r] * (1.0f / 256.0f) + 1e-6f);
        }
        const size_t tok0 = (size_t)b * 8192 + qrow0;
#pragma unroll
        for (int n = 0; n < 8; ++n) { const float sg = subg[32 * n + r32];
#pragma unroll
            for (int r = 0; r < 16; ++r) xch[crow(r, hi) * 256 + 32 * n + r32] = O[n][r] * ssq[r] * sg; }
        int lane2 = threadIdx.x & 63; asm volatile("" : "+v"(lane2));
#pragma unroll 4
        for (int i = 0; i < 16; ++i) { const int row = (lane2 >> 5) + 2 * i, c = lane2 & 31;
            const f32x4 v0 = *(const LAS f32x4*)(xch + row * 256 + c * 8), v1 = *(const LAS f32x4*)(xch + row * 256 + c * 8 + 4);
            const size_t idx = (tok0 + row) * 2048 + h * 256 + c * 8;
            const u32x4 gg = *(const u32x4*)(G + idx);
            u32x4 w; w.x = cvtpk(v0[0] * bflo(gg.x), v0[1] * bfhi(gg.x)); w.y = cvtpk(v0[2] * bflo(gg.y), v0[3] * bfhi(gg.y)); w.z = cvtpk(v1[0] * bflo(gg.z), v1[1] * bfhi(gg.z)); w.w = cvtpk(v1[2] * bflo(gg.w), v1[3] * bfhi(gg.w));
            *(u32x4*)(AO + idx) = w; }
    }
    __syncthreads();
}
#undef DA_VADDR
}

namespace swa {
__device__ __forceinline__ void unit(LAS unsigned char* lds, LAS float* wscr, const bf16_t* Q, const bf16_t* K, const bf16_t* V, const bf16_t* G, bf16_t* AO, const float* sinks, int b, int kvh, int nb) {
    const int tid = threadIdx.x, lane = tid & 63, wid = __builtin_amdgcn_readfirstlane(tid >> 6), r32 = lane & 31, hi = lane >> 5;
    const int q4 = (lane & 15) >> 2, p4 = lane & 3, blk = (lane >> 4) & 1;
    LAS unsigned char* Ks = lds; LAS unsigned char* Vs = lds + 32768;
    const bf16_t* Kg = K + (size_t)(b * 4 + kvh) * 8192 * 64; const bf16_t* Vg = V + (size_t)(b * 4 + kvh) * 8192 * 64;
#pragma unroll
    for (int i = 0; i < 4; ++i) { const int id = tid + 512 * i, row = id >> 3, ch = id & 7, kabs = 128 * (nb - 1) + row;
        u32x4 kv = (u32x4){0u, 0u, 0u, 0u}, vv = (u32x4){0u, 0u, 0u, 0u};
        if (kabs >= 0) { kv = *(const u32x4*)(Kg + (size_t)kabs * 64 + ch * 8); vv = *(const u32x4*)(Vg + (size_t)kabs * 64 + ch * 8); }
        *(LAS u32x4*)(Ks + off128k(row, ch)) = kv; *(LAS u32x4*)(Vs + off128v(row, ch)) = vv; }
    __syncthreads();
    const int head = kvh * 8 + wid;
    const float sk = sinks[head] * LOG2E;
    const bf16_t* Qh = Q + ((size_t)(b * 32 + head) * 8192 + nb * 128) * 64;
    for (int i = 0; i < 4; ++i) {
        bf16x8 qf[4];
#pragma unroll
        for (int d0 = 0; d0 < 4; ++d0) qf[d0] = *(const bf16x8*)(Qh + (size_t)(32 * i + r32) * 64 + d0 * 16 + hi * 8);
        f32x16 sc[5];
        const int qq = 128 + 32 * i + r32;
        float mx = sk;
#pragma unroll
        for (int jj = 0; jj < 5; ++jj) { const int j = i + jj;
#pragma unroll
            for (int r = 0; r < 16; ++r) sc[jj][r] = 0.f;
#pragma unroll
            for (int d0 = 0; d0 < 4; ++d0) { const bf16x8 kf = *(const LAS bf16x8*)(Ks + off128k(32 * j + r32, 2 * d0 + hi)); sc[jj] = MFMA32(kf, qf[d0], sc[jj]); }
            if (jj == 0 || jj == 4 || nb == 0) {
#pragma unroll
                for (int r = 0; r < 16; ++r) { const int kk = 32 * j + crow(r, hi); const bool ok = (kk <= qq) && (qq - kk < 128) && (nb > 0 || kk >= 128);
                    sc[jj][r] = ok ? sc[jj][r] : -1e30f; }
            }
#pragma unroll
            for (int r = 0; r < 16; ++r) mx = fmaxf(mx, sc[jj][r]);
        }
        mx = fmaxf(mx, __shfl_xor(mx, 32));
        float ls = 0.f;
#pragma unroll
        for (int jj = 0; jj < 5; ++jj)
#pragma unroll
            for (int r = 0; r < 16; ++r) { sc[jj][r] = __builtin_amdgcn_exp2f(sc[jj][r] - mx); ls += sc[jj][r]; }
        ls += __shfl_xor(ls, 32);
        ls += __builtin_amdgcn_exp2f(sk - mx);
        f32x16 O[2];
#pragma unroll
        for (int n = 0; n < 2; ++n)
#pragma unroll
            for (int r = 0; r < 16; ++r) O[n][r] = 0.f;
#pragma unroll
        for (int jj = 0; jj < 5; ++jj)
#pragma unroll
            for (int c = 0; c < 2; ++c) {
                const bf16x8 pa = pack8(sc[jj][8 * c + 0], sc[jj][8 * c + 1], sc[jj][8 * c + 2], sc[jj][8 * c + 3], sc[jj][8 * c + 4], sc[jj][8 * c + 5], sc[jj][8 * c + 6], sc[jj][8 * c + 7]);
                const int vr = 32 * (i + jj) + 16 * c + 4 * hi + q4;
#pragma unroll
                for (int n = 0; n < 2; ++n) { const int ch = 4 * n + 2 * blk + (p4 >> 1);
                    const s16x4 lo = trrd(Vs + off128v(vr, ch) + 8 * (p4 & 1)), hh = trrd(Vs + off128v(vr + 8, ch) + 8 * (p4 & 1));
                    O[n] = MFMA32(pa, cat4(lo, hh), O[n]); }
            }
        wscr[r32] = 1.0f / ls;
        f32x4 a4[4];
#pragma unroll
        for (int gq = 0; gq < 4; ++gq) a4[gq] = *(const LAS f32x4*)(wscr + 8 * gq + 4 * hi);
        const size_t tok0 = (size_t)b * 8192 + nb * 128 + 32 * i;
        LAS float* stg = (LAS float*)(lds + 65536 + wid * 8192);
#pragma unroll
        for (int n = 0; n < 2; ++n)
#pragma unroll
            for (int r = 0; r < 16; ++r) stg[crow(r, hi) * 64 + 32 * n + r32] = O[n][r] * a4[r >> 2][r & 3];
#pragma unroll
        for (int k4 = 0; k4 < 4; ++k4) { const int row = (lane >> 3) + 8 * k4, c = lane & 7;
            const f32x4 v0 = *(const LAS f32x4*)(stg + row * 64 + c * 8), v1 = *(const LAS f32x4*)(stg + row * 64 + c * 8 + 4);
            const size_t idx = (tok0 + row) * 2048 + head * 64 + c * 8;
            const u32x4 gg = *(const u32x4*)(G + idx);
            u32x4 w; w.x = cvtpk(v0[0] * bflo(gg.x), v0[1] * bfhi(gg.x)); w.y = cvtpk(v0[2] * bflo(gg.y), v0[3] * bfhi(gg.y)); w.z = cvtpk(v1[0] * bflo(gg.z), v1[1] * bfhi(gg.z)); w.w = cvtpk(v1[2] * bflo(gg.w), v1[3] * bfhi(gg.w));
            *(u32x4*)(AO + idx) = w; }
    }
    __syncthreads();
}
}

namespace ml {
__device__ __forceinline__ void gate_carry(float* sc, int bh, int lane) {
    const float a0 = sc[SC_BLC + bh * 128 + lane], a1 = sc[SC_BLC + bh * 128 + 64 + lane], c0 = sc[SC_CML + bh * 128 + lane], c1 = sc[SC_CML + bh * 128 + 64 + lane];
    float m = 0.f, segsum = 0.f, mstart = 0.f;
    for (int c = 0; c < 128; ++c) {
        const int l = c & 63;
        const float bL = __uint_as_float(__builtin_amdgcn_readlane(__float_as_uint(c < 64 ? a0 : a1), l)), cmL = __uint_as_float(__builtin_amdgcn_readlane(__float_as_uint(c < 64 ? c0 : c1), l));
        if (lane == 0) sc[SC_MC + bh * 129 + c] = m;
        const float mnew = bL + fmaxf(m, cmL);
        segsum += bL;
        if ((c & 7) == 7) { if (lane == 0) sc[SC_SD + bh * 16 + (c >> 3)] = expf(segsum + mstart - mnew); segsum = 0.f; mstart = mnew; }
        m = mnew;
    }
    if (lane == 0) sc[SC_MC + bh * 129 + 128] = m;
}
constexpr int L_Q = 0, L_K = 16384, L_V = 32768, L_VW = 65536, L_A = 98304, L_SC = 106496, L_H = 110592, HROW = 520;
__device__ __forceinline__ void store_h(const LAS unsigned char* lds, bf16_t* hs0, int tid) {
#pragma unroll
    for (int i = 0; i < 4; ++i) { const int id = tid + 512 * i, row = id >> 5, c16 = id & 31;
        const u32x2 lo = *(const LAS u32x2*)(lds + L_H + row * HROW + c16 * 16), hi2 = *(const LAS u32x2*)(lds + L_H + row * HROW + c16 * 16 + 8);
        *(u32x4*)(hs0 + (size_t)row * 2048 + c16 * 8) = (u32x4){lo.x, lo.y, hi2.x, hi2.y}; }
}
template <bool FULL, int VAR = 0> __device__ __forceinline__ void seg_pass(LAS unsigned char* lds, const bf16_t* Q, const bf16_t* K, const bf16_t* V, const float* sc, float* Est, float* En, bf16_t* HS, int bh, int seg) {
    int tid = threadIdx.x; asm volatile("" : "+v"(tid));
    const int lane = tid & 63, wid = __builtin_amdgcn_readfirstlane(tid >> 6), r32 = lane & 31, hi = lane >> 5;
    const int q4 = (lane & 15) >> 2, p4 = lane & 3, blk = (lane >> 4) & 1;
    const int b = bh >> 3, h = bh & 7;
    LAS float* sbl = (LAS float*)(lds + L_SC); LAS float* sii = sbl + 64; LAS float* smt = sbl + 128; LAS float* swk = sbl + 192; LAS float* rows = sbl + 256; LAS float* nq = sbl + 384; LAS float* nvec = sbl + 448;
    const bf16_t* Qg = Q + (size_t)bh * 8192 * 128; const bf16_t* Kg = K + (size_t)bh * 8192 * 128; const bf16_t* Vg = V + (size_t)bh * 8192 * 256;
    const float* gbl = sc + SC_BL + bh * 8192; const float* gii = sc + SC_II + bh * 8192; const float* gmt = sc + SC_MT + bh * 8192; const float* gmc = sc + SC_MC + bh * 129;
    f32x16 CT[4];
    float* Eb = Est + (size_t)(bh * 16 + seg) * 32768 + (size_t)(wid * 4) * 1024;
    if (FULL) {
        const float* e = Eb + lane;
#pragma unroll
        for (int dt = 0; dt < 4; ++dt) {
#pragma unroll
            for (int r = 0; r < 16; ++r) CT[dt][r] = e[r * 64];
            e += 1024; asm volatile("" : "+v"(e)); }
        if (tid < 128) nvec[tid] = En[(size_t)(bh * 16 + seg) * 128 + tid];
    } else {
#pragma unroll
        for (int dt = 0; dt < 4; ++dt)
#pragma unroll
            for (int r = 0; r < 16; ++r) CT[dt][r] = 0.f;
        if (tid < 128) nvec[tid] = 0.f;
    }
    for (int cc = 0; cc < 8; ++cc) {
        const int c = seg * 8 + cc, t0 = 64 * c;
        const float m_in = gmc[c], m_out = gmc[c + 1], bL = gbl[t0 + 63];
        __syncthreads();
        if (FULL && cc > 0) store_h(lds, HS + ((size_t)b * 8192 + t0 - 64) * 2048 + h * 256, tid);
        if (VAR != 2 || cc == 0) {
#pragma unroll
        for (int i = 0; i < 2; ++i) { const int id = tid + 512 * i, row = id >> 4, ch = id & 15;
            if (FULL) *(LAS u32x4*)(lds + L_Q + off256(row, ch)) = *(const u32x4*)(Qg + (size_t)(t0 + row) * 128 + ch * 8);
            *(LAS u32x4*)(lds + L_K + off256(row, ch)) = *(const u32x4*)(Kg + (size_t)(t0 + row) * 128 + ch * 8); }
#pragma unroll
        for (int i = 0; i < 4; ++i) { const int id = lane + 64 * i, row = id >> 2, cq = id & 3;
            const u32x4 vv = *(const u32x4*)(Vg + (size_t)(t0 + row) * 256 + wid * 32 + cq * 8);
            const float wk = __expf(bL - gbl[t0 + row] + gii[t0 + row] - m_out);
            u32x4 vw; vw.x = cvtpk(bflo(vv.x) * wk, bfhi(vv.x) * wk); vw.y = cvtpk(bflo(vv.y) * wk, bfhi(vv.y) * wk); vw.z = cvtpk(bflo(vv.z) * wk, bfhi(vv.z) * wk); vw.w = cvtpk(bflo(vv.w) * wk, bfhi(vv.w) * wk);
            if (FULL) *(LAS u32x4*)(lds + L_V + off512(row, 4 * wid + cq)) = vv;
            *(LAS u32x4*)(lds + L_VW + off512(row, 4 * wid + cq)) = vw; }
        if (tid < 64) { const float bl_ = gbl[t0 + tid], ii_ = gii[t0 + tid]; sbl[tid] = bl_; sii[tid] = ii_; smt[tid] = bl_ + fmaxf(m_in, gmt[t0 + tid]); swk[tid] = __expf(bL - bl_ + ii_ - m_out); }
        }
        __syncthreads();
        __builtin_amdgcn_sched_barrier(0);
        if (FULL) {
            if (wid < 4) {
                const int st = wid >> 1, tt = wid & 1, t = 32 * tt + r32;
                f32x16 s;
#pragma unroll
                for (int r = 0; r < 16; ++r) s[r] = 0.f;
                if (!(st == 1 && tt == 0)) {
#pragma unroll
                    for (int d0 = 0; d0 < 8; ++d0) { const bf16x8 kf = *(const LAS bf16x8*)(lds + L_K + off256(32 * st + r32, 2 * d0 + hi)); const bf16x8 qv = *(const LAS bf16x8*)(lds + L_Q + off256(t, 2 * d0 + hi)); s = MFMA32(kf, qv, s); }
                }
                const float sat = sbl[t] - smt[t];
                float rs = 0.f;
#pragma unroll
                for (int gq = 0; gq < 4; ++gq) { const int s0 = 32 * st + 8 * gq + 4 * hi;
                    const f32x4 bi = *(const LAS f32x4*)(sii + s0), bb = *(const LAS f32x4*)(sbl + s0);
                    float a[4];
#pragma unroll
                    for (int e = 0; e < 4; ++e) { const float w = (s0 + e <= t) ? __expf(sat + bi[e] - bb[e]) : 0.f; a[e] = s[4 * gq + e] * w; rs += a[e]; }
                    u32x2 pk; pk.x = cvtpk(a[0], a[1]); pk.y = cvtpk(a[2], a[3]);
                    *(LAS u32x2*)(lds + L_A + off128k(t, 4 * st + gq) + 8 * hi) = pk; }
                rs += __shfl_xor(rs, 32);
                if (hi == 0) rows[st * 64 + t] = rs;
            } else {
                const int idx = tid - 256, t = idx >> 2, part = idx & 3; float p = 0.f;
#pragma unroll
                for (int c4 = 0; c4 < 4; ++c4) { const u32x4 qv = *(const LAS u32x4*)(lds + L_Q + off256(t, 4 * part + c4)); const LAS float* nv = nvec + 32 * part + 8 * c4;
                    p += bflo(qv.x) * nv[0] + bfhi(qv.x) * nv[1] + bflo(qv.y) * nv[2] + bfhi(qv.y) * nv[3] + bflo(qv.z) * nv[4] + bfhi(qv.z) * nv[5] + bflo(qv.w) * nv[6] + bfhi(qv.w) * nv[7]; }
                p += __shfl_xor(p, 1); p += __shfl_xor(p, 2);
                if (part == 0) nq[t] = p;
            }
            __syncthreads();
            __builtin_amdgcn_sched_barrier(0);
#pragma unroll 1
            for (int tt = 0; tt < 2; ++tt) {
                const int t = 32 * tt + r32;
                f32x16 acc;
#pragma unroll
                for (int r = 0; r < 16; ++r) acc[r] = 0.f;
#pragma unroll
                for (int dt = 0; dt < 4; ++dt)
#pragma unroll
                    for (int c2 = 0; c2 < 2; ++c2) {
                        const bf16x8 A = pack8(CT[dt][8 * c2 + 0], CT[dt][8 * c2 + 1], CT[dt][8 * c2 + 2], CT[dt][8 * c2 + 3], CT[dt][8 * c2 + 4], CT[dt][8 * c2 + 5], CT[dt][8 * c2 + 6], CT[dt][8 * c2 + 7]);
                        const s16x4 lo = *(const LAS s16x4*)(lds + L_Q + off256(t, 4 * dt + 2 * c2) + 8 * hi), hh = *(const LAS s16x4*)(lds + L_Q + off256(t, 4 * dt + 2 * c2 + 1) + 8 * hi);
                        acc = MFMA32(A, cat4(lo, hh), acc);
                    }
                const float wi = __expf(sbl[t] + m_in - smt[t]);
#pragma unroll
                for (int r = 0; r < 16; ++r) acc[r] *= wi;
#pragma unroll 1
                for (int cs = 0; cs < 4; ++cs) { const int vr = 16 * cs + 8 * hi + q4, ch = 4 * wid + 2 * blk + (p4 >> 1);
                    const s16x4 lo = trrd(lds + L_V + off512(vr, ch) + 8 * (p4 & 1)), hh = trrd(lds + L_V + off512(vr + 4, ch) + 8 * (p4 & 1));
                    const bf16x8 B = *(const LAS bf16x8*)(lds + L_A + off128k(t, 2 * cs + hi));
                    acc = MFMA32(cat4(lo, hh), B, acc); }
                const float dn = rows[t] + rows[64 + t] + wi * nq[t];
                const float inv = 1.0f / fmaxf(fabsf(dn), __expf(-smt[t]));
#pragma unroll
                for (int gq = 0; gq < 4; ++gq) { u32x2 pk; pk.x = cvtpk(acc[4 * gq] * inv, acc[4 * gq + 1] * inv); pk.y = cvtpk(acc[4 * gq + 2] * inv, acc[4 * gq + 3] * inv);
                    *(LAS u32x2*)(lds + L_H + t * HROW + (wid * 32 + 8 * gq + 4 * hi) * 2) = pk; }
            }
        }
        __builtin_amdgcn_sched_barrier(0);
        const float decay = __expf(bL + m_in - m_out);
#pragma unroll
        for (int dt = 0; dt < 4; ++dt)
#pragma unroll
            for (int r = 0; r < 16; ++r) CT[dt][r] *= decay;
#pragma unroll 1
        for (int cs = 0; cs < 4; ++cs) { const int vr = 16 * cs + 8 * hi + q4, chv = 4 * wid + 2 * blk + (p4 >> 1);
            const s16x4 bl0 = trrd(lds + L_VW + off512(vr, chv) + 8 * (p4 & 1)), bh0 = trrd(lds + L_VW + off512(vr + 4, chv) + 8 * (p4 & 1));
            const bf16x8 B = cat4(bl0, bh0);
#pragma unroll
            for (int dt = 0; dt < 4; ++dt) { const int chk = 4 * dt + 2 * blk + (p4 >> 1);
                const s16x4 al = trrd(lds + L_K + off256(vr, chk) + 8 * (p4 & 1)), ah = trrd(lds + L_K + off256(vr + 4, chk) + 8 * (p4 & 1));
                CT[dt] = MFMA32(cat4(al, ah), B, CT[dt]); } }
        if (wid >= 4) {
            const int idx = tid - 256, d = idx >> 1, half = idx & 1; float p = 0.f;
#pragma unroll 8
            for (int s = 0; s < 32; ++s) { const int sr = 32 * half + s; p += swk[sr] * bf2f(*(const LAS unsigned short*)(lds + L_K + off256(sr, d >> 3) + 2 * (d & 7))); }
            p += __shfl_xor(p, 1);
            if (half == 0) nvec[d] = decay * nvec[d] + p;
        }
    }
    if (FULL) { __syncthreads(); store_h(lds, HS + ((size_t)b * 8192 + (seg * 8 + 7) * 64) * 2048 + h * 256, tid); }
    if (!FULL) {
#pragma unroll
        for (int dt = 0; dt < 4; ++dt)
#pragma unroll
            for (int r = 0; r < 16; ++r) Eb[(dt * 16 + r) * 64 + lane] = CT[dt][r];
        __syncthreads();
        if (tid < 128) En[(size_t)(bh * 16 + seg) * 128 + tid] = nvec[tid];
    }
    __syncthreads();
}
__device__ __forceinline__ void seg_scan(float* Est, float* En, const float* sc, int gtid, int ngt) {
    for (int e = gtid; e < 16 * (32768 + 128); e += ngt) {
        const int bh = e / (32768 + 128), i = e - bh * (32768 + 128);
        float* p = (i < 32768) ? Est + (size_t)bh * 16 * 32768 + i : En + (size_t)bh * 16 * 128 + (i - 32768);
        const size_t stride = (i < 32768) ? 32768 : 128;
        float run = 0.f;
        for (int sg = 0; sg < 16; ++sg) { const float tmp = p[sg * stride]; p[sg * stride] = run; run = sc[SC_SD + bh * 16 + sg] * run + tmp; }
    }
}
__device__ __forceinline__ void finalize(bf16_t* HS, const bf16_t* SO, const bf16_t* SG, const float* ng, int gw, int NGW, int lane) {
    const f32x4 gv = ((const f32x4*)ng)[lane];
    for (int row = gw; row < TOK; row += NGW) {
        u32x2* hp = (u32x2*)(HS + (size_t)row * DM) + lane; const u32x2* op = (const u32x2*)(SO + (size_t)row * DM) + lane; const u32x2* gp = (const u32x2*)(SG + (size_t)row * DM) + lane;
#pragma unroll
        for (int j = 0; j < 8; ++j) { const u32x2 hv = hp[64 * j], ov = op[64 * j], sg = gp[64 * j];
            const float x0 = bflo(hv.x), x1 = bfhi(hv.x), x2 = bflo(hv.y), x3 = bfhi(hv.y);
            const float r = 1.0f / sqrtf(wave_sum((x0 * x0 + x1 * x1) + (x2 * x2 + x3 * x3)) * (1.0f / 256.0f) + 1e-6f);
            u32x2 w; w.x = cvtpk(x0 * r * gv.x * bflo(ov.x) * bflo(sg.x), x1 * r * gv.y * bfhi(ov.x) * bfhi(sg.x)); w.y = cvtpk(x2 * r * gv.z * bflo(ov.y) * bflo(sg.y), x3 * r * gv.w * bfhi(ov.y) * bfhi(sg.y));
            hp[64 * j] = w; }
    }
}
}
#define XB_TMO      128
#define XB_XCNT(j)  (256  + 64 * (j))
#define XB_XSUB(j)  (1280 + 64 * (j))
#define XB_XGEN(j)  (2304 + 64 * (j))
#define XB_TOP      3328
#define XB_TOPGEN   3392
#define XCD_BAR_WORDS 3456
#define XB_SPIN_CAP (1u << 18)

__device__ __forceinline__ unsigned xb_ld(unsigned* p)              { return __hip_atomic_load(p, __ATOMIC_RELAXED, __HIP_MEMORY_SCOPE_AGENT); }
__device__ __forceinline__ unsigned xb_add(unsigned* p, unsigned v) { return __hip_atomic_fetch_add(p, v, __ATOMIC_RELAXED, __HIP_MEMORY_SCOPE_AGENT); }
__device__ __forceinline__ unsigned xb_xcc_id() { return (unsigned)__builtin_amdgcn_s_getreg((3 << 11) | 20) & 0xFu; }
#define XB_SPIN(cond, bar) do { unsigned _sp = 0; while (cond) { __builtin_amdgcn_s_sleep(1); \
    if ((++_sp & 255u) == 0u) { if (xb_ld(&(bar)[XB_TMO])) break; if (_sp > XB_SPIN_CAP) { atomicAdd(&(bar)[XB_TMO], 1u); break; } } } } while (0)

struct XcdBarrier {
    unsigned* bar; unsigned x;
    volatile LAS unsigned* st;
};

__device__ __forceinline__ XcdBarrier xcd_barrier_post(unsigned* bar, volatile LAS unsigned* st) {
    XcdBarrier b; b.bar = bar; b.x = xb_xcc_id(); b.st = st;
    if (threadIdx.x == 0) (void)xb_add(&bar[XB_XCNT(b.x)], 1u);
    return b;
}
__device__ __forceinline__ void xcd_barrier_complete(unsigned* bar, unsigned x, unsigned& nloc, unsigned& nx) {
    const unsigned G = gridDim.x * gridDim.y * gridDim.z;
    unsigned sum, cnt, mine, sp = 0u;
    for (;;) {
        sum = 0u; cnt = 0u; mine = 0u;
#pragma unroll
        for (unsigned j = 0; j < 16; ++j) { const unsigned c = xb_ld(&bar[XB_XCNT(j)]); sum += c; cnt += (c > 0u) ? 1u : 0u; mine = (j == x) ? c : mine; }
        if (sum == G) break;
        __builtin_amdgcn_s_sleep(1);
        if ((++sp & 255u) == 0u) { if (xb_ld(&bar[XB_TMO])) break; if (sp > XB_SPIN_CAP) { atomicAdd(&bar[XB_TMO], 1u); break; } }
    }
    nloc = mine > 0u ? mine : 1u; nx = cnt > 0u ? cnt : 1u;
}

__device__ __forceinline__ void xcd_barrier(const XcdBarrier& b) {
    asm volatile("s_waitcnt vmcnt(0)" ::: "memory");
    __syncthreads();
    if (threadIdx.x == 0) {
        unsigned* bar = b.bar;
        __builtin_amdgcn_s_waitcnt(0);
        unsigned nloc = b.st[0], nx = b.st[1];
        if (nloc == 0u) { xcd_barrier_complete(bar, b.x, nloc, nx); b.st[0] = nloc; b.st[1] = nx; }
        const unsigned old = xb_add(&bar[XB_XSUB(b.x)], 1u);
        const unsigned gen = old / nloc;
        if (old + 1u == (gen + 1u) * nloc) {
            __builtin_amdgcn_fence(__ATOMIC_RELEASE, "agent");
            asm volatile("s_waitcnt vmcnt(0)" ::: "memory");
            const unsigned og = xb_add(&bar[XB_TOP], 1u);
            const unsigned tg = og / nx;
            if (og + 1u == (tg + 1u) * nx) xb_add(&bar[XB_TOPGEN], 1u);
            else XB_SPIN(xb_ld(&bar[XB_TOPGEN]) == tg, bar);
            __builtin_amdgcn_fence(__ATOMIC_ACQUIRE, "agent");
            xb_add(&bar[XB_XGEN(b.x)], 1u);
            asm volatile("s_waitcnt vmcnt(0)" ::: "memory");
        } else {
            XB_SPIN(xb_ld(&bar[XB_XGEN(b.x)]) == gen, bar);
            __builtin_amdgcn_fence(__ATOMIC_ACQUIRE, "agent");
            asm volatile("s_waitcnt vmcnt(0)" ::: "memory");
        }
    }
    __syncthreads();
}

struct Args {
    const float* x; const int* pos; const float* norm_g; const float* final_g;
    const float* da_w_in; const float* da_w_out; const float* da_lambda; const float* da_subln;
    const float* sw_w_in; const float* sw_w_out; const float* sw_sinks;
    const float* ml_w_in; const float* ml_b_gates; const float* ml_w_out; const float* ml_norm_g;
    float* out; unsigned char* ws; int ph_lo, ph_hi;
};
#ifndef PROBE_EXTRA
#define PROBE_EXTRA 0
#endif
constexpr int N_PHASES = 20 + PROBE_EXTRA;
#ifndef MK_LAUNCHES
#define MK_LAUNCHES 1
#endif

__device__ __forceinline__ float da_lambda_full(const float* lam, float lambda_init, int lane) {
    float a = lam[lane] * lam[128 + lane] + lam[64 + lane] * lam[128 + 64 + lane];
    float c = lam[256 + lane] * lam[384 + lane] + lam[256 + 64 + lane] * lam[384 + 64 + lane];
    a = wave_sum(a); c = wave_sum(c);
    return expf(a) - expf(c) + lambda_init;
}

__global__ void __launch_bounds__(512, 2) hybrid_fwd(Args args) {
    extern __shared__ __attribute__((aligned(16))) unsigned char lds_raw[];
    LAS unsigned char* lds = (LAS unsigned char*)lds_raw;
    cg::grid_group grid = cg::this_grid();
    const int tid0 = threadIdx.x, wave = __builtin_amdgcn_readfirstlane(tid0 >> 6);
    const int G = gridDim.x, bx = blockIdx.x, vcu = (G % 8 == 0) ? (bx % 8) * (G / 8) + bx / 8 : bx;
    const int gw = vcu * NWAVES + wave, NGW = G * NWAVES, ngt = G * 512;
    unsigned char* ws = args.ws;
    bf16_t* HN = (bf16_t*)(ws + WS_HN); bf16_t* ACT = (bf16_t*)(ws + WS_ACT);
    float* SCN = (float*)(ws + WS_SCAN); float* GIF = (float*)(ws + WS_GIF);
    LAS float* wscr = (LAS float*)(lds + MISC_OFF) + wave * 64;
    (void)gw; (void)ngt;
    const int lo = args.ph_lo, hi = args.ph_hi;
    volatile LAS unsigned* xb_st = (volatile LAS unsigned*)(lds + LDS_BYTES - 16);
    if (tid0 < 2) xb_st[tid0] = 0u;
    __syncthreads();
    XcdBarrier xbar = xcd_barrier_post((unsigned*)(ws + 4096), xb_st);
    if (args.ph_lo == 0x7fffffff) grid.sync();
    int ph = 0;
#ifndef PROBE_MLV
#define PROBE_MLV 0
#endif
#ifndef PROBE_REP
#define PROBE_REP 0u
#endif
#ifndef PH_MASK
#define PH_MASK 0xFFFFFFFu
#endif
#define PHASE_BEGIN if (((PH_MASK >> ph) & 1u) && ph >= lo && ph < hi) { int tid = tid0; asm volatile("" : "+v"(tid)); const int lane = tid & 63, gtid = vcu * 512 + tid; (void)lane; (void)gtid;
#define PHASE_END   if (ph + 1 < hi) xcd_barrier(xbar); } ++ph;

    PHASE_BEGIN
        LAS float* scr = (LAS float*)(lds + wave * 16640);
        { constexpr int I_IN = 32 * 128, I_OUT = 32 * 32, I_SW = 32 * 72;
          const CvMat ma{args.da_w_in, (bf16_t*)(ws + WS_W_DA0_IN), 8192, 8192, 1}, mb{args.sw_w_in, (bf16_t*)(ws + WS_W_SW_IN), 4608, 4608, 2},
                      mc{args.da_w_out, (bf16_t*)(ws + WS_W_DA0_OUT), 2048, 2048, 0}, md{args.sw_w_out, (bf16_t*)(ws + WS_W_SW_OUT), 2048, 2048, 0};
          convert_set(ma, mb, mc, md, I_IN, I_SW, I_OUT, I_OUT, gw, NGW, scr, lane); }
        rope_table(args.pos, 64, (float*)(ws + WS_ROPEA_C), (float*)(ws + WS_ROPEA_S), gtid, ngt);
        rope_table(args.pos, 32, (float*)(ws + WS_ROPEB_C), (float*)(ws + WS_ROPEB_S), gtid, ngt);
        norm_rows<false>(args.x, args.norm_g, HN, gw, NGW, lane, nullptr, nullptr, nullptr);
    PHASE_END
#ifdef PROBE_P0
    PHASE_BEGIN
        LAS float* scr = (LAS float*)(lds + wave * 16640);
        { constexpr int I_IN = 32 * 128, I_OUT = 32 * 32, I_SW = 32 * 72;
          const CvMat ma{args.da_w_in, (bf16_t*)(ws + WS_W_DA0_IN), 8192, 8192, 1}, mb{args.sw_w_in, (bf16_t*)(ws + WS_W_SW_IN), 4608, 4608, 2},
                      mc{args.da_w_out, (bf16_t*)(ws + WS_W_DA0_OUT), 2048, 2048, 0}, md{args.sw_w_out, (bf16_t*)(ws + WS_W_SW_OUT), 2048, 2048, 0};
          convert_set(ma, mb, mc, md, I_IN, I_SW, I_OUT, I_OUT, gw, NGW, scr, lane); }
        rope_table(args.pos, 64, (float*)(ws + WS_ROPEA_C), (float*)(ws + WS_ROPEA_S), gtid, ngt);
        rope_table(args.pos, 32, (float*)(ws + WS_ROPEB_C), (float*)(ws + WS_ROPEB_S), gtid, ngt);
        norm_rows<false>(args.x, args.norm_g, HN, gw, NGW, lane, nullptr, nullptr, nullptr);
    PHASE_END
#endif

#define GEMM_IN(KIND, WOFF, NCOLS, COST, SINT) GEMM_IN2(KIND, WOFF, NCOLS, COST, SINT, 0)
#define GEMM_IN2(KIND, WOFF, NCOLS, COST, SINT, SKIP) do { asm volatile("s_waitcnt vmcnt(0)" ::: "memory"); \
        pg8::Gemm g_{HN, (const bf16_t*)(ws + (WOFF)), TOK, (NCOLS), 2048}; pg8::StaticOrder S_; S_.init(TOK, (NCOLS), G, bx); \
        pg8::EpiProj E_{(KIND), ACT, (const float*)(ws + (COST)), (const float*)(ws + (SINT)), (SKIP)}; \
        pg8::gemm_phase<pg8::EpiProj, pg8::StaticOrder, true, true>(lds, g_, S_, E_); } while (0)
#define GEMM_OUT(WOFF, XIN) do { asm volatile("s_waitcnt vmcnt(0)" ::: "memory"); \
        pg8::Gemm g_{HN, (const bf16_t*)(ws + (WOFF)), TOK, 2048, 2048}; pg8::StaticOrder S_; S_.init(TOK, 2048, G, bx); \
        pg8::EpiRes E_{(XIN), args.out}; \
        pg8::gemm_phase<pg8::EpiRes, pg8::StaticOrder, true, true>(lds, g_, S_, E_); } while (0)
#define DA_ATTN(LAYER_J, LAMBDA_INIT, VARIANT) do { \
        const float lamf_ = da_lambda_full(args.da_lambda + (LAYER_J) * 512, (LAMBDA_INIT), lane); \
        for (int idx_ = vcu; idx_ < 1024; idx_ += G) { const int rnd_ = idx_ >> 8, w_ = idx_ & 255, bh_ = w_ >> 4, s_ = w_ & 15; \
            const int qb_ = rnd_ == 0 ? 63 - s_ : rnd_ == 1 ? 32 + s_ : rnd_ == 2 ? 31 - s_ : s_; \
            da::unit<VARIANT>(lds, wscr, ACT, ACT + 32 * pg8::ACT_MiB, ACT + 64 * pg8::ACT_MiB, ACT + 96 * pg8::ACT_MiB, HN, args.da_subln + (LAYER_J) * 256, lamf_, 1.0f - (LAMBDA_INIT), bh_ >> 3, bh_ & 7, qb_); } } while (0)

    PHASE_BEGIN GEMM_IN(0, WS_W_DA0_IN, 8192, WS_ROPEA_C, WS_ROPEA_S); PHASE_END
#ifdef PROBE_GEMM
    PHASE_BEGIN GEMM_IN2(0, WS_W_DA0_IN, 8192, WS_ROPEA_C, WS_ROPEA_S, PROBE_GEMM - 1); PHASE_END
#endif
    PHASE_BEGIN DA_ATTN(0, 0.2f, 0); PHASE_END
#ifdef PROBE_ATTN
    PHASE_BEGIN DA_ATTN(0, 0.2f, PROBE_ATTN); PHASE_END
#endif
    PHASE_BEGIN GEMM_OUT(WS_W_DA0_OUT, args.x); PHASE_END
    PHASE_BEGIN norm_rows<false>(args.out, args.norm_g + 2048, HN, gw, NGW, lane, nullptr, nullptr, nullptr); PHASE_END
#ifdef PROBE_NORM
    PHASE_BEGIN norm_rows<false>(args.out, args.norm_g + 2048, HN, gw, NGW, lane, nullptr, nullptr, nullptr); PHASE_END
#endif
#ifdef PROBE_SYNC
    for (int i_ = 0; i_ < 20; ++i_) grid.sync();
#endif
    PHASE_BEGIN
        GEMM_IN(1, WS_W_SW_IN, 4608, WS_ROPEB_C, WS_ROPEB_S);
        if (bx >= G / 2) {
            LAS float* scr = (LAS float*)(lds + wave * 16640);
            constexpr int I_IN = 32 * 128, I_OUT = 32 * 32;
            const int gw2 = (bx - G / 2) * NWAVES + wave, NGW2 = (G - G / 2) * NWAVES;
            const CvMat ma{args.ml_w_in, (bf16_t*)(ws + WS_W_ML_IN), 8208, 8192, 3}, mb{args.da_w_in + (size_t)2048 * 8192, (bf16_t*)(ws + WS_W_DA1_IN), 8192, 8192, 1},
                        mc{args.ml_w_out, (bf16_t*)(ws + WS_W_ML_OUT), 2048, 2048, 0}, md{args.da_w_out + (size_t)2048 * 2048, (bf16_t*)(ws + WS_W_DA1_OUT), 2048, 2048, 0};
            convert_set(ma, mb, mc, md, I_IN, I_IN, I_OUT, I_OUT, gw2, NGW2, scr, lane);
        }
    PHASE_END
    PHASE_BEGIN
        for (int u = vcu; u < 512; u += G) swa::unit(lds, wscr, ACT, ACT + 32 * pg8::ACT_MiB, ACT + 36 * pg8::ACT_MiB, ACT + 96 * pg8::ACT_MiB, HN, args.sw_sinks, u >> 8, (u >> 6) & 3, u & 63);
    PHASE_END
#ifdef PROBE_SWA
    PHASE_BEGIN
        for (int u = vcu; u < 512; u += G) swa::unit(lds, wscr, ACT, ACT + 32 * pg8::ACT_MiB, ACT + 36 * pg8::ACT_MiB, ACT + 96 * pg8::ACT_MiB, HN, args.sw_sinks, u >> 8, (u >> 6) & 3, u & 63);
    PHASE_END
#endif
    PHASE_BEGIN GEMM_OUT(WS_W_SW_OUT, args.out); PHASE_END
    PHASE_BEGIN
        { LAS float* wg = (LAS float*)lds;
          for (int i = tid; i < 2048 * 16; i += 512) { const int k = i >> 4, j = i & 15; wg[j * 2048 + k] = args.ml_w_in[(size_t)k * 8208 + 6144 + j]; }
          __syncthreads();
          for (int cidx = vcu; cidx < 256; cidx += G) norm_gif_chunk(args.out, args.norm_g + 2 * 2048, HN, wg, (LAS float*)(lds + MISC_OFF + 4096), args.ml_b_gates, SCN, cidx, wave, lane); }
    PHASE_END
    PHASE_BEGIN
        if (vcu < 16 && wave == 0) ml::gate_carry(SCN, vcu, lane);
        GEMM_IN(2, WS_W_ML_IN, 8192, WS_ROPEA_C, WS_ROPEA_S);
    PHASE_END
    PHASE_BEGIN
        for (int u = vcu; u < 256; u += G) ml::seg_pass<false>(lds, ACT, ACT + 16 * pg8::ACT_MiB, ACT + 32 * pg8::ACT_MiB, SCN, (float*)(ws + WS_MLSTATE), (float*)(ws + WS_MLN), HN, u >> 4, u & 15);
    PHASE_END
#if defined(PROBE_ML) && PROBE_ML != 3
    PHASE_BEGIN
        for (int u = vcu; u < 256; u += G) ml::seg_pass<false>(lds, ACT, ACT + 16 * pg8::ACT_MiB, ACT + 32 * pg8::ACT_MiB, SCN, (float*)(ws + WS_MLSTATE), (float*)(ws + WS_MLN), HN, u >> 4, u & 15);
    PHASE_END
#endif
    PHASE_BEGIN ml::seg_scan((float*)(ws + WS_MLSTATE), (float*)(ws + WS_MLN), SCN, gtid, ngt); PHASE_END
    PHASE_BEGIN
        for (int u = vcu; u < 256; u += G) ml::seg_pass<true>(lds, ACT, ACT + 16 * pg8::ACT_MiB, ACT + 32 * pg8::ACT_MiB, SCN, (float*)(ws + WS_MLSTATE), (float*)(ws + WS_MLN), HN, u >> 4, u & 15);
    PHASE_END
#if defined(PROBE_ML) && PROBE_ML != 2
    PHASE_BEGIN
        for (int u = vcu; u < 256; u += G) ml::seg_pass<true, PROBE_MLV>(lds, ACT, ACT + 16 * pg8::ACT_MiB, ACT + 32 * pg8::ACT_MiB, SCN, (float*)(ws + WS_MLSTATE), (float*)(ws + WS_MLN), HN, u >> 4, u & 15);
    PHASE_END
#endif
    PHASE_BEGIN ml::finalize(HN, ACT + 64 * pg8::ACT_MiB, ACT + 96 * pg8::ACT_MiB, args.ml_norm_g, gw, NGW, lane); PHASE_END
    PHASE_BEGIN GEMM_OUT(WS_W_ML_OUT, args.out); PHASE_END
    PHASE_BEGIN norm_rows<false>(args.out, args.norm_g + 3 * 2048, HN, gw, NGW, lane, nullptr, nullptr, nullptr); PHASE_END
#ifdef PROBE_NORM
    PHASE_BEGIN norm_rows<false>(args.out, args.norm_g + 3 * 2048, HN, gw, NGW, lane, nullptr, nullptr, nullptr); PHASE_END
#endif
    PHASE_BEGIN GEMM_IN(0, WS_W_DA1_IN, 8192, WS_ROPEA_C, WS_ROPEA_S); PHASE_END
#ifdef PROBE_GEMM
    PHASE_BEGIN GEMM_IN2(0, WS_W_DA1_IN, 8192, WS_ROPEA_C, WS_ROPEA_S, PROBE_GEMM - 1); PHASE_END
#endif
    PHASE_BEGIN DA_ATTN(1, 0.55605820924f, 0); PHASE_END
    PHASE_BEGIN GEMM_OUT(WS_W_DA1_OUT, args.out); PHASE_END
    PHASE_BEGIN final_norm_rows(args.out, args.final_g, gw, NGW, lane); PHASE_END
}

extern "C" void kernel_launch(void* const* d_in, const int* in_sizes, int n_in, void* d_out, int out_size, void* d_ws, size_t ws_size, hipStream_t stream) {
    static int grid = 0;
    if (grid == 0) {
        if (n_in != 15 || out_size != TOK * DM || ws_size < WS_END) { fprintf(stderr, "kernel_launch: unexpected problem (n_in %d out %d ws %zu)\n", n_in, out_size, ws_size); grid = -1; return; }
        int dev = 0, cus = 0, per_cu = 0;
        hipGetDevice(&dev); hipDeviceGetAttribute(&cus, hipDeviceAttributeMultiprocessorCount, dev);
        if (hipFuncSetAttribute((const void*)hybrid_fwd, hipFuncAttributeMaxDynamicSharedMemorySize, LDS_BYTES) != hipSuccess) { fprintf(stderr, "kernel_launch: hipFuncSetAttribute failed\n"); grid = -1; return; }
        hipOccupancyMaxActiveBlocksPerMultiprocessor(&per_cu, (const void*)hybrid_fwd, 512, LDS_BYTES);
        (void)hipGetLastError();
        if (per_cu < 1) per_cu = 1;
        grid = cus * 1;
        fprintf(stderr, "kernel_launch: %d CUs, occupancy query %d block(s)/CU, grid %d\n", cus, per_cu, grid);
    }
    if (grid < 0) return;
    if (hipMemsetAsync(d_ws, 0, 65536, stream) != hipSuccess) { fprintf(stderr, "kernel_launch: memset of the barrier words failed\n"); return; }
    Args a{};
    a.x = (const float*)d_in[0]; a.pos = (const int*)d_in[1]; a.norm_g = (const float*)d_in[2]; a.final_g = (const float*)d_in[3];
    a.da_w_in = (const float*)d_in[4]; a.da_w_out = (const float*)d_in[5]; a.da_lambda = (const float*)d_in[6]; a.da_subln = (const float*)d_in[7];
    a.sw_w_in = (const float*)d_in[8]; a.sw_w_out = (const float*)d_in[9]; a.sw_sinks = (const float*)d_in[10];
    a.ml_w_in = (const float*)d_in[11]; a.ml_b_gates = (const float*)d_in[12]; a.ml_w_out = (const float*)d_in[13]; a.ml_norm_g = (const float*)d_in[14];
    a.out = (float*)d_out; a.ws = (unsigned char*)d_ws;
#if MK_LAUNCHES == 1
    a.ph_lo = 0; a.ph_hi = N_PHASES;
    { void* kargs[] = {&a}; hipError_t e = hipLaunchCooperativeKernel((const void*)hybrid_fwd, dim3(grid), dim3(512), kargs, LDS_BYTES, stream);
      if (e != hipSuccess) fprintf(stderr, "cooperative launch failed: %s (grid %d)\n", hipGetErrorString(e), grid); }
#else
    for (int p = 0; p < N_PHASES; ++p) { a.ph_lo = p; a.ph_hi = p + 1; void* kargs[] = {&a};
        hipError_t e = hipLaunchCooperativeKernel((const void*)hybrid_fwd, dim3(grid), dim3(512), kargs, LDS_BYTES, stream);
        if (e != hipSuccess) { fprintf(stderr, "cooperative launch %d failed: %s (grid %d)\n", p, hipGetErrorString(e), grid); break; } }
#endif
}
```

```cpp
#include <hip/hip_runtime.h>
#include <hip/hip_cooperative_groups.h>
#include <cstdio>
#include <cstdint>
namespace cg = cooperative_groups;
#define LAS __attribute__((address_space(3)))
typedef unsigned short bf16_t;
typedef short bf16x8 __attribute__((ext_vector_type(8)));
typedef short s16x4 __attribute__((ext_vector_type(4)));
typedef float f32x4 __attribute__((ext_vector_type(4)));
typedef float f32x16 __attribute__((ext_vector_type(16)));
typedef unsigned u32x4 __attribute__((ext_vector_type(4)));
typedef unsigned u32x2 __attribute__((ext_vector_type(2)));
__device__ __forceinline__ unsigned cvtpk(float lo, float hi) { typedef float f2_t __attribute__((ext_vector_type(2))); typedef __bf16 b2_t __attribute__((ext_vector_type(2))); f2_t v = {lo, hi}; b2_t b = __builtin_convertvector(v, b2_t); return __builtin_bit_cast(unsigned, b); }
__device__ __forceinline__ float bf2f(unsigned short v) { return __uint_as_float(((unsigned)v) << 16); }
__device__ __forceinline__ float bflo(unsigned v) { return __uint_as_float(v << 16); }
__device__ __forceinline__ float bfhi(unsigned v) { return __uint_as_float(v & 0xffff0000u); }
constexpr float LOG2E = 1.4426950408889634f;
__device__ __forceinline__ float fsigmoid(float x) { return 1.0f / (1.0f + __expf(-x)); }
namespace pg8 {
#define PG8_LAS __attribute__((address_space(3)))
typedef unsigned short bf16_t;
typedef short bf16x8 __attribute__((ext_vector_type(8)));
typedef float f32x4 __attribute__((ext_vector_type(4)));
typedef unsigned u32x4 __attribute__((ext_vector_type(4)));
constexpr int BM = 256, BK = 64, HALF = 128, HTB = HALF * BK * 2  , STAGE_BYTES = 8 * HTB, NXCD = 8, WGM = 8;

__host__ __device__ __forceinline__ int lds_byte(int r, int c) { const int st = (r >> 4) * 2 + (c >> 5), rr = r & 15, cc = c & 31, ob = rr * 64 + cc * 2; return st * 1024 + (ob ^ (((ob >> 9) & 1) << 5)); }
__host__ __device__ __forceinline__ void stage_rc(int b, int& R, int& C) { const int st = b / 1024, sb = b % 1024, swz = sb ^ (((sb >> 9) & 1) << 5); R = (st >> 1) * 16 + swz / 64; C = (st & 1) * 32 + (swz % 64) / 2; }
__host__ __device__ __forceinline__ int perm32(int rho) { const int n = rho >> 4, i = rho & 15; return 8 * (i >> 2) + 4 * n + (i & 3); }

struct Unit { int pm, pn; };
struct Gemm { const bf16_t* A; const bf16_t* Bt; int M, N, K; };

struct StaticOrder {
    int nM, nN, nwg, G, c;
    __host__ __device__ void init(int M, int N, int G_, int c_) { nM = M / BM; nN = N / BM; nwg = nM * nN; G = G_; c = c_; }
    __host__ __device__ bool next(int i, Unit& u) const {
        const long L = (long)i * G + c; if (L >= nwg) return false;
        int wgid = (int)L; { const int q = nwg / NXCD, r = nwg % NXCD, xcd = wgid % NXCD, off = wgid / NXCD; wgid = (xcd < r ? xcd * (q + 1) : r * (q + 1) + (xcd - r) * q) + off; }
        const int nig = WGM * nN, gid = wgid / nig, fm = gid * WGM, gsz = (nM - fm) < WGM ? (nM - fm) : WGM;
        u.pm = fm + ((wgid % nig) % gsz); u.pn = (wgid % nig) / gsz; return true;
    }
    __device__ __forceinline__ void a_ready(const Unit&) const {}
    __device__ __forceinline__ void done(const Unit&) const {}
};

__device__ __forceinline__ void epi_plain(const f32x4 (&acc)[2][2][4][2], bf16_t* base, size_t stride, size_t ct0, size_t ct1, int act, float scale, int wr, int fr) {
    bf16_t* rowp = base + (size_t)(wr * 64 + fr) * stride;
#pragma unroll
    for (int ai = 0; ai < 2; ++ai)
#pragma unroll
        for (int m = 0; m < 4; ++m) {
#pragma unroll
            for (int bj = 0; bj < 2; ++bj) { f32x4 v0 = acc[ai][bj][m][0], v1 = acc[ai][bj][m][1];
                if (act == 0) { v0 = v0 * scale; v1 = v1 * scale; }
                else {
#pragma unroll
                    for (int j = 0; j < 4; ++j) { const float s0 = __builtin_amdgcn_rcpf(1.0f + __expf(-v0[j])), s1 = __builtin_amdgcn_rcpf(1.0f + __expf(-v1[j])); v0[j] = (act == 1) ? v0[j] * s0 : s0; v1[j] = (act == 1) ? v1[j] * s1 : s1; } }
                u32x4 w; w.x = ::cvtpk(v0[0], v0[1]); w.y = ::cvtpk(v0[2], v0[3]); w.z = ::cvtpk(v1[0], v1[1]); w.w = ::cvtpk(v1[2], v1[3]);
                *(u32x4*)(rowp + (bj ? ct1 : ct0)) = w; }
            rowp += (m == 3 ? (size_t)(HALF - 48) : (size_t)16) * stride;
            asm volatile("" : "+v"(rowp) :: "memory"); }
}
__device__ __forceinline__ void epi_rope(const f32x4 (&acc)[2][2][4][2], bf16_t* rowp, size_t adv_m, size_t adv_m1, size_t adv_ai, size_t half_off, const float* cp, const float* sp, int tstride, float scale) {
#pragma unroll
    for (int ai = 0; ai < 2; ++ai)
#pragma unroll
        for (int m = 0; m < 4; ++m) {
            { const f32x4 c0 = *(const f32x4*)(cp), c1 = *(const f32x4*)(cp + 4), s0 = *(const f32x4*)(sp), s1 = *(const f32x4*)(sp + 4);
              const f32x4 a0 = acc[ai][0][m][0], a1 = acc[ai][0][m][1], b0 = acc[ai][1][m][0], b1 = acc[ai][1][m][1];
              const f32x4 o10 = (a0 * c0 - b0 * s0) * scale, o11 = (a1 * c1 - b1 * s1) * scale, o20 = (b0 * c0 + a0 * s0) * scale, o21 = (b1 * c1 + a1 * s1) * scale;
              u32x4 w; w.x = ::cvtpk(o10[0], o10[1]); w.y = ::cvtpk(o10[2], o10[3]); w.z = ::cvtpk(o11[0], o11[1]); w.w = ::cvtpk(o11[2], o11[3]);
              *(u32x4*)rowp = w;
              w.x = ::cvtpk(o20[0], o20[1]); w.y = ::cvtpk(o20[2], o20[3]); w.z = ::cvtpk(o21[0], o21[1]); w.w = ::cvtpk(o21[2], o21[3]);
              *(u32x4*)(rowp + half_off) = w; }
            const size_t adv = (m == 3 ? (size_t)(HALF - 48) : (size_t)16);
            rowp += (m == 3 ? adv_ai : (m == 1 ? adv_m1 : adv_m)); cp += adv * tstride; sp += adv * tstride;
            asm volatile("" : "+v"(rowp), "+v"(cp), "+v"(sp) :: "memory"); }
}
constexpr size_t ACT_MiB = 1u << 20;
struct EpiProj {
    static constexpr bool PERM = true, AFTER_DRAIN = false;
    int kind; bf16_t* act; const float* cosT; const float* sinT; int skip;
    __device__ __forceinline__ void operator()(const f32x4 (&acc)[2][2][4][2], const Unit& u, int wr, int wc, int fr, int fq) const {
        if (skip) {
            f32x4 t = acc[0][0][0][0];
#pragma unroll
            for (int a = 0; a < 2; ++a)
#pragma unroll
                for (int b2 = 0; b2 < 2; ++b2)
#pragma unroll
                    for (int m = 0; m < 4; ++m)
#pragma unroll
                        for (int n = 0; n < 2; ++n) t += acc[a][b2][m][n];
            if (t[0] + t[1] + t[2] + t[3] == 12345.678f) act[0] = 1;
            return; }
        const int pn = u.pn, row0 = u.pm * BM, b = row0 >> 13, s0 = row0 & 8191;
        const size_t cp = (size_t)(wc * 32 + 8 * fq);
        bf16_t* G = act + 96 * ACT_MiB;
        const int rl0 = wr * 64 + fr;
        bool rope = false; bf16_t* base = G; size_t stride = 2048, ct0 = cp, ct1 = 128 + cp; int ac = 1; float scale = 1.0f;
        if (kind == 0) {
            if (pn < 16) {
                rope = true;
                const int h = pn & 7, isk = pn >> 3, map = wc >> 1, c1 = (wc & 1) * 32 + 8 * fq;
                const float* cpp = cosT + (size_t)(row0 + rl0) * 64 + c1; const float* spp = sinT + (size_t)(row0 + rl0) * 64 + c1;
                if (!isk) { bf16_t* q = act + ((size_t)((b * 8 + h) * 2 + map) * 8192 + s0 + rl0) * 128 + c1;
                    epi_rope(acc, q, 16 * 128, 16 * 128, (size_t)(HALF - 48) * 128, 64, cpp, spp, 64, 0.08838834764831845f * LOG2E); }
                else {
                    bf16_t* k = act + 32 * ACT_MiB + ((size_t)((b * 8 + h) * 2 + map) * 8192 + s0) * 128 + (size_t)(2 * wr) * 4096 + (size_t)(c1 >> 3) * 256 + (size_t)fr * 8;
                    epi_rope(acc, k, 128, 4096 - 128, (size_t)3 * 4096 - 128, 8 * 256, cpp, spp, 64, 1.0f); }
            } else if (pn < 24) { base = act + 64 * ACT_MiB + ((size_t)(b * 8 + (pn - 16)) * 8192 + s0) * 256; stride = 256; ac = 0; }
            else base = G + (size_t)row0 * 2048 + (pn - 24) * 256;
        } else if (kind == 1) {
            if (pn < 9) {
                rope = true;
                const int c1 = 8 * fq;
                bf16_t* bq = (pn < 8) ? act + ((size_t)(b * 32 + pn * 4 + wc) * 8192 + s0 + rl0) * 64 + c1 : act + 32 * ACT_MiB + ((size_t)(b * 4 + wc) * 8192 + s0 + rl0) * 64 + c1;
                epi_rope(acc, bq, 16 * 64, 16 * 64, (size_t)(HALF - 48) * 64, 32, cosT + (size_t)(row0 + rl0) * 32 + c1, sinT + (size_t)(row0 + rl0) * 32 + c1, 32, (pn < 8) ? 0.125f * LOG2E : 1.0f);
            } else if (pn == 9) {
                base = act + 36 * ACT_MiB + ((size_t)(b * 4) * 8192 + s0) * 64; stride = 64; ac = 0;
                ct0 = (size_t)(wc >> 1) * 8192 * 64 + (wc & 1) * 32 + 8 * fq; ct1 = ct0 + (size_t)2 * 8192 * 64;
            } else base = G + (size_t)row0 * 2048 + (pn - 10) * 256;
        } else {
            if (pn < 8) {
                base = act + ((pn < 4) ? 0 : 16 * ACT_MiB) + ((size_t)(b * 8) * 8192 + s0) * 128; stride = 128; ac = 0;
                ct0 = (size_t)(2 * (pn & 3)) * 8192 * 128 + cp; ct1 = ct0 + (size_t)8192 * 128; scale = (pn < 4) ? 0.08838834764831845f : 1.0f;
            } else if (pn < 16) { base = act + 32 * ACT_MiB + ((size_t)(b * 8 + (pn - 8)) * 8192 + s0) * 256; stride = 256; ac = 0; }
            else if (pn < 24) { base = act + 64 * ACT_MiB + (size_t)row0 * 2048 + (pn - 16) * 256; ac = 2; }
            else base = G + (size_t)row0 * 2048 + (pn - 24) * 256;
        }
        if (!rope) epi_plain(acc, base, stride, ct0, ct1, ac, scale, wr, fr);
    }
};
struct EpiRes {
    static constexpr bool PERM = false, AFTER_DRAIN = false;
    const float* xin; float* xout;
    __device__ __forceinline__ void operator()(const f32x4 (&acc)[2][2][4][2], const Unit& u, int wr, int wc, int fr, int fq) const {
        const int col0 = u.pn * BM + wc * 32 + 4 * fq;
#pragma unroll
        for (int ai = 0; ai < 2; ++ai)
#pragma unroll
            for (int m = 0; m < 4; ++m) { const size_t off = (size_t)(u.pm * BM + ai * HALF + wr * 64 + m * 16 + fr) * 2048 + col0;
#pragma unroll
                for (int bj = 0; bj < 2; ++bj)
#pragma unroll
                    for (int n = 0; n < 2; ++n) { const f32x4 bs = *(const f32x4*)(xin + off + bj * HALF + n * 16); *(f32x4*)(xout + off + bj * HALF + n * 16) = bs + acc[ai][bj][m][n]; }
                if (m & 1) asm volatile("" ::: "memory"); }
    }
};
template <class Epi, class Sched, bool ALIGN_EPI = false, bool SP2 = false>
__device__ __forceinline__ void gemm_phase(PG8_LAS unsigned char* lds, const Gemm g, const Sched& S, const Epi& E) {
    const int tid = threadIdx.x, wid = __builtin_amdgcn_readfirstlane(tid >> 6), lane = tid & 63, wr = wid >> 2, wc = wid & 3, fr = lane & 15, fq = lane >> 4;
    const int K = g.K, nt = K / BK;
    unsigned voffA[2], voffB[2];
#pragma unroll
    for (int i = 0; i < 2; ++i) { int R, C; stage_rc(tid * 16 + i * 8192, R, C); const int Rb = Epi::PERM ? ((R & ~31) + perm32(R & 31)) : R;
        voffA[i] = (unsigned)(R * K + C) * 2u; voffB[i] = (unsigned)(Rb * K + C) * 2u; }
    const size_t kstep = (size_t)(BK * 2);
    const size_t hstep = (size_t)HALF * K * 2;
    const size_t tstep = 2 * hstep;
    const unsigned ldsw = (unsigned)wid * 1024u;
    const int aoff = lds_byte(wr * 64 + fr, fq * 8), boff = lds_byte(wc * 32 + fr, fq * 8);
#define PG8_SA(b, h) (((b) * 2 + (h)) * HTB)
#define PG8_SB(b, h) ((4 + (b) * 2 + (h)) * HTB)
#define PG8_STAGE(bufoff, gbase, voff) do { _Pragma("unroll") for (int _i = 0; _i < 2; ++_i) \
        __builtin_amdgcn_global_load_lds((const unsigned*)((const char*)(gbase) + (voff)[_i]), (PG8_LAS unsigned*)(lds + (bufoff) + ldsw + _i * 8192), 16, 0, 0); } while (0)
#define PG8_LDA(dst, b, h) do { _Pragma("unroll") for (int m = 0; m < 4; ++m) _Pragma("unroll") for (int k = 0; k < 2; ++k) dst[m][k] = *(const PG8_LAS bf16x8*)(lds + PG8_SA(b, h) + aoff + m * 2048 + k * 1024); } while (0)
#define PG8_LDB(dst, b, h) do { _Pragma("unroll") for (int n = 0; n < 2; ++n) _Pragma("unroll") for (int k = 0; k < 2; ++k) dst[n][k] = *(const PG8_LAS bf16x8*)(lds + PG8_SB(b, h) + boff + n * 2048 + k * 1024); } while (0)
#define PG8_MMA(ai, bj, At, Bt) do { __builtin_amdgcn_s_setprio(1); _Pragma("unroll") for (int m = 0; m < 4; ++m) _Pragma("unroll") for (int n = 0; n < 2; ++n) _Pragma("unroll") for (int k = 0; k < 2; ++k) \
        acc[ai][bj][m][n] = __builtin_amdgcn_mfma_f32_16x16x32_bf16(Bt[n][k], At[m][k], acc[ai][bj][m][n], 0, 0, 0); __builtin_amdgcn_s_setprio(0); } while (0)
#define PG8_WAIT_V(n) asm volatile("s_waitcnt vmcnt(" #n ")" ::: "memory")
#define PG8_WAIT_L(n) asm volatile("s_waitcnt lgkmcnt(" #n ")" ::: "memory")
#define PG8_BAR __builtin_amdgcn_s_barrier()
#define PG8_SCHED __builtin_amdgcn_sched_barrier(0)
    Unit cur, nxt; int ui = 0;
    if (!S.next(0, cur)) return;
    f32x4 acc[2][2][4][2];
#pragma unroll
    for (int a = 0; a < 2; ++a)
#pragma unroll
        for (int b = 0; b < 2; ++b)
#pragma unroll
            for (int m = 0; m < 4; ++m)
#pragma unroll
                for (int n = 0; n < 2; ++n) acc[a][b][m][n] = (f32x4){0.f, 0.f, 0.f, 0.f};
    bf16x8 At[4][2], B0[2][2], B1[2][2];
    const char* cA = (const char*)g.A + (size_t)cur.pm * tstep; const char* cB = (const char*)g.Bt + (size_t)cur.pn * tstep;
    S.a_ready(cur);
    if constexpr (SP2) {
        PG8_STAGE(PG8_SB(0, 0), cB, voffB); PG8_STAGE(PG8_SB(0, 1), cB + hstep, voffB); PG8_STAGE(PG8_SA(0, 0), cA, voffA); PG8_STAGE(PG8_SA(0, 1), cA + hstep, voffA);
        if (wr == 1) PG8_BAR;
        PG8_WAIT_V(2); PG8_BAR;
        PG8_STAGE(PG8_SB(1, 0), cB + kstep, voffB); PG8_STAGE(PG8_SA(1, 0), cA + kstep, voffA); PG8_STAGE(PG8_SB(1, 1), cB + hstep + kstep, voffB);
        PG8_WAIT_V(6); PG8_BAR;
    } else {
        PG8_STAGE(PG8_SB(0, 0), cB, voffB); PG8_STAGE(PG8_SA(0, 0), cA, voffA); PG8_STAGE(PG8_SB(0, 1), cB + hstep, voffB); PG8_STAGE(PG8_SA(0, 1), cA + hstep, voffA);
        if (wr == 1) PG8_BAR;
        PG8_WAIT_V(4); PG8_BAR;
        PG8_STAGE(PG8_SB(1, 0), cB + kstep, voffB); PG8_STAGE(PG8_SA(1, 0), cA + kstep, voffA); PG8_STAGE(PG8_SB(1, 1), cB + hstep + kstep, voffB);
        PG8_WAIT_V(6); PG8_BAR;
    }
    for (;;) {
        const bool has_next = S.next(ui + 1, nxt);
        const char* nA = has_next ? (const char*)g.A + (size_t)nxt.pm * tstep : cA; const char* nB = has_next ? (const char*)g.Bt + (size_t)nxt.pn * tstep : cB;
        for (int t = 0; t < nt; t += 2) {
            const bool last = (t == nt - 2);
            const char* a1 = cA + (size_t)(t + 1) * kstep;
            const char* a2 = last ? nA : cA + (size_t)(t + 2) * kstep; const char* b2 = last ? nB : cB + (size_t)(t + 2) * kstep;
            const char* a3 = a2 + kstep; const char* b3 = b2 + kstep;
            if (last && has_next) S.a_ready(nxt);
            if constexpr (SP2) {
            PG8_LDB(B0, 0, 0); PG8_LDB(B1, 0, 1); PG8_SCHED; PG8_LDA(At, 0, 0); PG8_STAGE(PG8_SA(1, 1), a1 + hstep, voffA);
            PG8_WAIT_V(8); PG8_WAIT_L(0); PG8_BAR; PG8_MMA(0, 0, At, B0); PG8_MMA(0, 1, At, B1); PG8_BAR; PG8_SCHED;
            PG8_LDA(At, 0, 1); PG8_STAGE(PG8_SB(0, 0), b2, voffB); PG8_STAGE(PG8_SB(0, 1), b2 + hstep, voffB); PG8_STAGE(PG8_SA(0, 0), a2, voffA);
            PG8_WAIT_V(8); PG8_WAIT_L(0); PG8_BAR; PG8_MMA(1, 0, At, B0); PG8_MMA(1, 1, At, B1); PG8_BAR; PG8_SCHED;
            PG8_LDB(B0, 1, 0); PG8_LDB(B1, 1, 1); PG8_SCHED; PG8_LDA(At, 1, 0); PG8_STAGE(PG8_SA(0, 1), a2 + hstep, voffA);
            PG8_WAIT_V(8); PG8_WAIT_L(0); PG8_BAR; PG8_MMA(0, 0, At, B0); PG8_MMA(0, 1, At, B1); PG8_BAR; PG8_SCHED;
            PG8_LDA(At, 1, 1); PG8_STAGE(PG8_SB(1, 0), b3, voffB); PG8_STAGE(PG8_SB(1, 1), b3 + hstep, voffB); PG8_STAGE(PG8_SA(1, 0), a3, voffA);
            PG8_WAIT_V(8); PG8_WAIT_L(0); PG8_BAR; PG8_MMA(1, 0, At, B0); PG8_MMA(1, 1, At, B1); PG8_BAR; PG8_SCHED;
            } else {
            PG8_LDB(B0, 0, 0); PG8_SCHED; PG8_LDA(At, 0, 0); PG8_STAGE(PG8_SA(1, 1), a1 + hstep, voffA);
            PG8_WAIT_L(8); PG8_BAR; PG8_WAIT_L(0); PG8_MMA(0, 0, At, B0); PG8_BAR; PG8_SCHED;
            PG8_LDB(B1, 0, 1); PG8_STAGE(PG8_SB(0, 0), b2, voffB);
            PG8_BAR; PG8_WAIT_L(0); PG8_MMA(0, 1, At, B1); PG8_BAR;
            PG8_LDA(At, 0, 1); PG8_STAGE(PG8_SA(0, 0), a2, voffA);
            PG8_BAR; PG8_WAIT_L(0); PG8_MMA(1, 0, At, B0); PG8_BAR; PG8_SCHED;
            PG8_STAGE(PG8_SB(0, 1), b2 + hstep, voffB);
            PG8_WAIT_V(6); PG8_BAR; PG8_MMA(1, 1, At, B1); PG8_BAR;
            PG8_LDB(B0, 1, 0); PG8_SCHED; PG8_LDA(At, 1, 0); PG8_STAGE(PG8_SA(0, 1), a2 + hstep, voffA);
            PG8_WAIT_L(8); PG8_BAR; PG8_WAIT_L(0); PG8_MMA(0, 0, At, B0); PG8_BAR; PG8_SCHED;
            PG8_LDB(B1, 1, 1); PG8_STAGE(PG8_SB(1, 0), b3, voffB);
            PG8_BAR; PG8_WAIT_L(0); PG8_MMA(0, 1, At, B1); PG8_BAR;
            PG8_LDA(At, 1, 1); PG8_STAGE(PG8_SA(1, 0), a3, voffA);
            PG8_BAR; PG8_WAIT_L(0); PG8_MMA(1, 0, At, B0); PG8_BAR; PG8_SCHED;
            PG8_STAGE(PG8_SB(1, 1), b3 + hstep, voffB);
            PG8_WAIT_V(6); PG8_BAR; PG8_MMA(1, 1, At, B1); PG8_BAR;
            }
        }
        if constexpr (ALIGN_EPI) { if (wr == 0) PG8_BAR; }
        if constexpr (!Epi::AFTER_DRAIN) { E(acc, cur, wr, wc, fr, fq); S.done(cur); }
        if (!has_next) break;
#pragma unroll
        for (int a = 0; a < 2; ++a)
#pragma unroll
            for (int b = 0; b < 2; ++b)
#pragma unroll
                for (int m = 0; m < 4; ++m)
#pragma unroll
                    for (int n = 0; n < 2; ++n) acc[a][b][m][n] = (f32x4){0.f, 0.f, 0.f, 0.f};
        cur = nxt; cA = nA; cB = nB; ++ui;
        if constexpr (ALIGN_EPI) { if (wr == 1) PG8_BAR; }
    }
    PG8_WAIT_V(0);
    if constexpr (!ALIGN_EPI) { if (wr == 0) PG8_BAR; }
    PG8_BAR;
    if constexpr (Epi::AFTER_DRAIN) { E.fused(acc, cur, wr, wc, fr, fq, lds, wid, lane); S.done(cur); }
#undef PG8_SA
#undef PG8_SB
#undef PG8_STAGE
#undef PG8_LDA
#undef PG8_LDB
#undef PG8_MMA
#undef PG8_WAIT_V
#undef PG8_WAIT_L
#undef PG8_BAR
#undef PG8_SCHED
}
}

constexpr int TOK = 16384, DM = 2048, SEQL = 8192;
constexpr size_t MiB = 1u << 20;
constexpr size_t WS_ROPEA_C = 1 * MiB, WS_ROPEA_S = 5 * MiB, WS_ROPEB_C = 9 * MiB, WS_ROPEB_S = 11 * MiB, WS_GIF = 13 * MiB, WS_SCAN = 14 * MiB;
constexpr size_t WS_W_DA0_IN = 16 * MiB, WS_W_DA0_OUT = 48 * MiB, WS_W_SW_IN = 56 * MiB, WS_W_SW_OUT = 74 * MiB, WS_W_ML_IN = 82 * MiB, WS_W_ML_OUT = 114 * MiB, WS_W_DA1_IN = 122 * MiB, WS_W_DA1_OUT = 154 * MiB;
constexpr size_t WS_HN = 162 * MiB, WS_ACT = 226 * MiB, WS_END = 482 * MiB;
constexpr size_t WS_MLSTATE = 16 * MiB;
constexpr size_t WS_MLN = 48 * MiB;
constexpr int SC_BL = 0, SC_II = 131072, SC_MT = 262144, SC_MC = 393216, SC_SD = 393216 + 4096;
constexpr int LDS_BYTES = 147456, RING_BYTES = 131072, MISC_OFF = 131072;
constexpr int NWAVES = 8;

__device__ __forceinline__ float wave_sum(float v) {
#pragma unroll
    for (int o = 1; o < 64; o <<= 1) v += __shfl_xor(v, o);
    return v;
}
__device__ __forceinline__ int crow(int r, int hi) { return (r & 3) + 8 * (r >> 2) + 4 * hi; }
__device__ __forceinline__ bf16x8 pack8(float a0, float a1, float a2, float a3, float a4, float a5, float a6, float a7) {
    u32x4 w; w.x = cvtpk(a0, a1); w.y = cvtpk(a2, a3); w.z = cvtpk(a4, a5); w.w = cvtpk(a6, a7); return __builtin_bit_cast(bf16x8, w);
}
__device__ __forceinline__ bf16x8 cat4(s16x4 lo, s16x4 hi) { return (bf16x8){lo[0], lo[1], lo[2], lo[3], hi[0], hi[1], hi[2], hi[3]}; }
typedef short v4i16_t __attribute__((ext_vector_type(4)));
__device__ __forceinline__ s16x4 trrd(const LAS unsigned char* p) { return __builtin_bit_cast(s16x4, __builtin_amdgcn_ds_read_tr16_b64_v4i16((LAS v4i16_t*)p)); }
#define MFMA32(a, b, c) __builtin_amdgcn_mfma_f32_32x32x16_bf16((a), (b), (c), 0, 0, 0)
__device__ __forceinline__ int off256(int row, int ch) { return row * 256 + ((ch ^ (row & 15)) << 4); }
__device__ __forceinline__ int off512(int row, int ch) { return row * 512 + ((ch ^ ((row & 3) << 2)) << 4); }
__device__ __forceinline__ int off128k(int row, int ch) { return row * 128 + ((ch ^ (row & 7)) << 4); }
__device__ __forceinline__ int off128v(int row, int ch) { return row * 128 + ((ch ^ (((row >> 1) & 1) << 2)) << 4); }

__device__ __forceinline__ void transpose_item(const float* W, int K, int Nsrc, bf16_t* WT, int n_phys0, int n_src0, int k0, LAS float* scr, int lane) {
#pragma unroll 8
    for (int i = 0; i < 32; ++i) { const int kk = 2 * i + (lane >> 5); scr[kk * 33 + (lane & 31)] = W[(size_t)(k0 + kk) * Nsrc + n_src0 + (lane & 31)]; }
    asm volatile("s_waitcnt lgkmcnt(0)" ::: "memory");
    const int c = lane & 7;
#pragma unroll
    for (int j = 0; j < 4; ++j) { const int n = (lane >> 3) + 8 * j; const LAS float* s = scr + (8 * c) * 33 + n;
        u32x4 o; o.x = cvtpk(s[0 * 33], s[1 * 33]); o.y = cvtpk(s[2 * 33], s[3 * 33]); o.z = cvtpk(s[4 * 33], s[5 * 33]); o.w = cvtpk(s[6 * 33], s[7 * 33]);
        *(u32x4*)(WT + (size_t)(n_phys0 + n) * K + k0 + 8 * c) = o; }
    asm volatile("s_waitcnt lgkmcnt(0)" ::: "memory");
}
__device__ __forceinline__ int src_col(int mode, int nb) {
    const int tile = nb >> 3, g = nb & 7, bj = g >> 2, wc = g & 3;
    if (mode == 1 && tile < 16) return tile * 256 + (wc >> 1) * 128 + ((wc & 1) + 2 * bj) * 32;
    if (mode == 2 && tile < 9) return tile * 256 + wc * 64 + bj * 32;
    int p = nb * 32;
    if (mode == 3 && p >= 6144) p += 16;
    return p;
}
struct CvMat { const float* W; bf16_t* WT; int Nsrc, Nphys, mode; };
__device__ __forceinline__ void cv_load(const CvMat& m, int item, int lane, f32x4 (&v)[16]) {
    const int nblk = m.Nphys / 64, kb = item / nblk, nb2 = item % nblk, k0 = kb * 64;
    const int col4 = (lane & 15) * 4, src = ((col4 >> 5) ? src_col(m.mode, 2 * nb2 + 1) : src_col(m.mode, 2 * nb2)) + (col4 & 31);
    const float* p = m.W + (size_t)(k0 + (lane >> 4)) * m.Nsrc + src;
#pragma unroll
    for (int i = 0; i < 16; ++i) v[i] = *(const f32x4*)(p + (size_t)(4 * i) * m.Nsrc);
}
__device__ __forceinline__ void cv_store(const CvMat& m, int item, int lane, const f32x4 (&v)[16], LAS float* scr) {
    const int nblk = m.Nphys / 64, kb = item / nblk, nb2 = item % nblk, k0 = kb * 64, n_phys0 = nb2 * 64, col4 = (lane & 15) * 4;
#pragma unroll
    for (int i = 0; i < 16; ++i) { LAS float* d = scr + (4 * i + (lane >> 4)) * 65 + col4; d[0] = v[i].x; d[1] = v[i].y; d[2] = v[i].z; d[3] = v[i].w; }
    asm volatile("s_waitcnt lgkmcnt(0)" ::: "memory");
    const int c = lane & 7;
#pragma unroll
    for (int j = 0; j < 8; ++j) { const int n = (lane >> 3) + 8 * j; const LAS float* sp = scr + (8 * c) * 65 + n;
        u32x4 o; o.x = cvtpk(sp[0 * 65], sp[1 * 65]); o.y = cvtpk(sp[2 * 65], sp[3 * 65]); o.z = cvtpk(sp[4 * 65], sp[5 * 65]); o.w = cvtpk(sp[6 * 65], sp[7 * 65]);
        *(u32x4*)(m.WT + (size_t)(n_phys0 + n) * 2048 + k0 + 8 * c) = o; }
    asm volatile("s_waitcnt lgkmcnt(0)" ::: "memory");
}
__device__ __forceinline__ void cv_decode(const CvMat& a, const CvMat& b, const CvMat& c, const CvMat& d, int na, int nb, int nc, int it, CvMat& m, int& r) {
    r = it; m = a;
    if (r >= na) { r -= na; m = b; if (r >= nb) { r -= nb; m = c; if (r >= nc) { r -= nc; m = d; } } }
}
__device__ __forceinline__ void convert_set(const CvMat& a, const CvMat& b, const CvMat& c, const CvMat& d, int na, int nb, int nc, int nd, int first, int step, LAS float* scr, int lane) {
    const int total = na + nb + nc + nd;
    if (first >= total) return;
    f32x4 v[16], vn[16]; CvMat m, mn; int r, rn;
    cv_decode(a, b, c, d, na, nb, nc, first, m, r); cv_load(m, r, lane, v);
    for (int it = first; it < total; it += step) {
        const bool more = it + step < total;
        if (more) { cv_decode(a, b, c, d, na, nb, nc, it + step, mn, rn); cv_load(mn, rn, lane, vn); }
        cv_store(m, r, lane, v, scr);
        if (more) { m = mn; r = rn;
#pragma unroll
            for (int i = 0; i < 16; ++i) v[i] = vn[i]; }
    }
}
template <bool GIF> __device__ __forceinline__ void norm_rows(const float* xin, const float* g, bf16_t* hn, int gw, int NGW, int lane, const LAS float* wg, const float* bg, float* gif) {
    for (int row = gw; row < TOK; row += NGW) {
        const f32x4* xr = (const f32x4*)(xin + (size_t)row * DM) + lane;
        f32x4 v[8]; float s = 0.f;
#pragma unroll
        for (int j = 0; j < 8; ++j) { v[j] = xr[64 * j]; s += (v[j].x * v[j].x + v[j].y * v[j].y) + (v[j].z * v[j].z + v[j].w * v[j].w); }
        const float r = 1.0f / sqrtf(wave_sum(s) * (1.0f / DM) + 1e-6f);
        u32x2* o8 = (u32x2*)(hn + (size_t)row * DM) + lane;
#pragma unroll
        for (int j = 0; j < 8; ++j) { const f32x4 gv = ((const f32x4*)g)[64 * j + lane]; v[j] = v[j] * r * gv; u32x2 w; w.x = cvtpk(v[j].x, v[j].y); w.y = cvtpk(v[j].z, v[j].w); o8[64 * j] = w; }
        if (GIF) {
            float mine = 0.f;
#pragma unroll 1
            for (int jj = 0; jj < 16; ++jj) { float p = 0.f;
#pragma unroll
                for (int j = 0; j < 8; ++j) { const f32x4 w = *(const LAS f32x4*)(wg + jj * 2048 + 256 * j + 4 * lane); p += (v[j].x * w.x + v[j].y * w.y) + (v[j].z * w.z + v[j].w * w.w); }
                p = wave_sum(p); if (lane == jj) mine = p; }
            if (lane < 16) gif[(size_t)row * 16 + lane] = mine + bg[lane];
        }
    }
}

constexpr int SC_BLC = 393216 + 8192, SC_CML = 393216 + 12288;
__device__ __forceinline__ void norm_gif_chunk(const float* xin, const float* g, bf16_t* hn, const LAS float* wg, LAS float* gl, const float* bg, float* sc, int cidx, int wave, int lane) {
    for (int i = 0; i < 8; ++i) {
        const int rl = wave * 8 + i, row = cidx * 64 + rl;
        const f32x4* xr = (const f32x4*)(xin + (size_t)row * DM) + lane;
        f32x4 v[8]; float s = 0.f;
#pragma unroll
        for (int j = 0; j < 8; ++j) { v[j] = xr[64 * j]; s += (v[j].x * v[j].x + v[j].y * v[j].y) + (v[j].z * v[j].z + v[j].w * v[j].w); }
        const float r = 1.0f / sqrtf(wave_sum(s) * (1.0f / DM) + 1e-6f);
        u32x2* o8 = (u32x2*)(hn + (size_t)row * DM) + lane;
#pragma unroll
        for (int j = 0; j < 8; ++j) { const f32x4 gv = ((const f32x4*)g)[64 * j + lane]; v[j] = v[j] * r * gv; u32x2 w; w.x = cvtpk(v[j].x, v[j].y); w.y = cvtpk(v[j].z, v[j].w); o8[64 * j] = w; }
        float mine = 0.f;
#pragma unroll 1
        for (int jj = 0; jj < 16; ++jj) { float p = 0.f;
#pragma unroll
            for (int j = 0; j < 8; ++j) { const f32x4 w = *(const LAS f32x4*)(wg + jj * 2048 + 256 * j + 4 * lane); p += (v[j].x * w.x + v[j].y * w.y) + (v[j].z * w.z + v[j].w * w.w); }
            p = wave_sum(p); if (lane == jj) mine = p; }
        if (lane < 16) gl[rl * 16 + lane] = mine + bg[lane];
    }
    __syncthreads();
    { const int h = wave, b = cidx >> 7, c = cidx & 127, bh = b * 8 + h, t = 64 * c + lane;
      const float ip = gl[lane * 16 + h], fp = gl[lane * 16 + 8 + h];
      const float lf = fminf(fp, 0.f) - log1pf(expf(-fabsf(fp)));
      float bs = lf;
#pragma unroll
      for (int o = 1; o < 64; o <<= 1) { const float vv = __shfl_up(bs, o); if (lane >= o) bs += vv; }
      float cm = ip - bs;
#pragma unroll
      for (int o = 1; o < 64; o <<= 1) { const float vv = __shfl_up(cm, o); if (lane >= o) cm = fmaxf(cm, vv); }
      sc[SC_BL + bh * 8192 + t] = bs; sc[SC_II + bh * 8192 + t] = ip; sc[SC_MT + bh * 8192 + t] = cm;
      if (lane == 63) { sc[SC_BLC + bh * 128 + c] = bs; sc[SC_CML + bh * 128 + c] = cm; } }
    __syncthreads();
}
__device__ __forceinline__ void final_norm_rows(float* x, const float* g, int gw, int NGW, int lane) {
    for (int row = gw; row < TOK; row += NGW) {
        f32x4* xr = (f32x4*)(x + (size_t)row * DM) + lane;
        f32x4 v[8]; float s = 0.f;
#pragma unroll
        for (int j = 0; j < 8; ++j) { v[j] = xr[64 * j]; s += (v[j].x * v[j].x + v[j].y * v[j].y) + (v[j].z * v[j].z + v[j].w * v[j].w); }
        const float r = 1.0f / sqrtf(wave_sum(s) * (1.0f / DM) + 1e-6f);
#pragma unroll
        for (int j = 0; j < 8; ++j) { const f32x4 gv = ((const f32x4*)g)[64 * j + lane]; xr[64 * j] = v[j] * r * gv; }
    }
}
__device__ __forceinline__ void rope_table(const int* pos, int nf, float* ct, float* st, int gtid, int ngt) {
    for (int i = gtid; i < TOK * nf; i += ngt) {
        const int tokn = i / nf, f = i - tokn * nf;
        const float invf = (float)exp2(-(double)f / (double)nf * 13.287712379549449);
        const float ang = (float)pos[tokn] * invf;
        double rv = (double)ang * 0.15915494309189535; rv -= floor(rv);
        const float rf = (float)rv;
        ct[i] = __builtin_amdgcn_cosf(rf); st[i] = __builtin_amdgcn_sinf(rf);
    }
}

namespace da {
constexpr int KSLOT = 16384, VBASE = 49152, VSLOT = 16384;
__device__ __forceinline__ void glds16(const void* gsrc, unsigned lds_dst) { unsigned keep;
    asm volatile("s_mov_b32 %0, m0\n\ts_mov_b32 m0, %2\n\ts_nop 0\n\tglobal_load_lds_dwordx4 %1, off\n\ts_mov_b32 m0, %0" : "=&s"(keep) : "v"(gsrc), "s"(lds_dst) : "memory"); }
__device__ __forceinline__ void issue_k(LAS unsigned char* lds, int slot, const bf16_t* K0, const bf16_t* K1, int t, int wid, int lane) {
    const unsigned d = (unsigned)(uintptr_t)(lds + slot * KSLOT + wid * 1024);
    glds16(K0 + (size_t)t * 4096 + (size_t)(wid * 64 + lane) * 8, (unsigned)__builtin_amdgcn_readfirstlane((int)d));
    glds16(K1 + (size_t)t * 4096 + (size_t)(wid * 64 + lane) * 8, (unsigned)__builtin_amdgcn_readfirstlane((int)(d + 8192u)));
}
__device__ __forceinline__ void issue_v(LAS unsigned char* lds, int slot, const bf16_t* V, int t, int wid, int lane) {
#pragma unroll
    for (int ii = 0; ii < 2; ++ii) { const int i = 2 * wid + ii, row = 2 * i + (lane >> 5), chp = lane & 31;
        const bf16_t* src = V + (size_t)(t * 32 + row) * 256 + ((chp ^ ((row & 3) << 2)) << 3);
        glds16(src, (unsigned)__builtin_amdgcn_readfirstlane((int)(unsigned)(uintptr_t)(lds + VBASE + slot * VSLOT + i * 1024))); }
}
#define DA_VADDR(i) (vq + (vb0 ^ (((i) & 3) << 6)) + ((((i) & 7) >> 2) * 256) + (16 * ((i) >> 3)) * 512)
__device__ __forceinline__ void pv_plain(f32x16 (&O)[8], const LAS unsigned char* vq, int vb0, bf16x8 pa0, bf16x8 pa1) {
    s16x4 vl[4], vh[4];
#pragma unroll
    for (int i = 0; i < 3; ++i) { vl[i] = trrd(DA_VADDR(i)); vh[i] = trrd(DA_VADDR(i) + 4096); }
    __builtin_amdgcn_sched_barrier(0);
#pragma unroll
    for (int i = 0; i < 16; ++i) {
        if (i + 3 < 16) { vl[(i + 3) & 3] = trrd(DA_VADDR(i + 3)); vh[(i + 3) & 3] = trrd(DA_VADDR(i + 3) + 4096); }
        O[i & 7] = MFMA32(i < 8 ? pa0 : pa1, cat4(vl[i & 3], vh[i & 3]), O[i & 7]);
        __builtin_amdgcn_sched_barrier(0);
    }
}
template <int VAR> __device__ __forceinline__ void unit(LAS unsigned char* lds, LAS float* wscr, const bf16_t* Q, const bf16_t* K, const bf16_t* V, const bf16_t* G, bf16_t* AO, const float* subg, float lam, float osc, int b, int h, int qb) {
    const int tid = threadIdx.x, lane = tid & 63, wid = __builtin_amdgcn_readfirstlane(tid >> 6), g = wid & 3, map = wid >> 2, r32 = lane & 31, hi = lane >> 5;
    const int q4 = (lane & 15) >> 2, p4 = lane & 3, blk = (lane >> 4) & 1;
    const bf16_t* K0 = K + (size_t)((b * 8 + h) * 2) * 8192 * 128; const bf16_t* K1 = K0 + (size_t)8192 * 128;
    const bf16_t* Vb = V + (size_t)(b * 8 + h) * 8192 * 256;
    const int qrow0 = qb * 128 + g * 32;
    const bf16_t* Qw = Q + ((size_t)((b * 8 + h) * 2 + map) * 8192 + qrow0) * 128;
    const int NT = 4 * qb + 4;
    issue_k(lds, 0, K0, K1, 0, wid, lane); issue_v(lds, 0, Vb, 0, wid, lane); issue_k(lds, 1, K0, K1, 1, wid, lane);
    bf16x8 qf[8];
#pragma unroll
    for (int d0 = 0; d0 < 8; ++d0) qf[d0] = *(const bf16x8*)(Qw + (size_t)r32 * 128 + d0 * 16 + hi * 8);
    f32x16 O[8];
#pragma unroll
    for (int n = 0; n < 8; ++n)
#pragma unroll
        for (int r = 0; r < 16; ++r) O[n][r] = 0.f;
    float mhat = -1e30f, lsum = 0.f;
    const int qabs = qrow0 + r32;
    const int vb0 = (4 * hi + q4) * 512 + (((4 * q4) + 2 * blk + (p4 >> 1)) << 4) + 8 * (p4 & 1);
    bf16x8 pa0, pa1;
#pragma unroll
    for (int j = 0; j < 8; ++j) { pa0[j] = 0; pa1[j] = 0; }
    int sl = 0, slp = 2;
    for (int t = 0; t < NT; ++t) {
        if (t + 2 < NT) asm volatile("s_waitcnt vmcnt(4)\n\ts_barrier" ::: "memory"); else asm volatile("s_waitcnt vmcnt(0)\n\ts_barrier" ::: "memory");
        if (t + 2 < NT) issue_k(lds, slp, K0, K1, t + 2, wid, lane);
        if (t + 1 < NT) issue_v(lds, (sl == 2 ? 0 : sl + 1), Vb, t + 1, wid, lane);
        if (VAR == 6) { slp = sl; sl = (sl == 2 ? 0 : sl + 1); continue; }
        const LAS unsigned char* kp = lds + sl * KSLOT + map * 8192 + hi * 512 + r32 * 16;
        const LAS unsigned char* vq = lds + VBASE + slp * VSLOT;
        f32x16 sc;
#pragma unroll
        for (int r = 0; r < 16; ++r) sc[r] = 0.f;
        { bf16x8 kf[2];
          kf[0] = *(const LAS bf16x8*)(kp);
          __builtin_amdgcn_sched_barrier(0);
#pragma unroll
          for (int d0 = 0; d0 < 8; ++d0) {
              if (d0 + 1 < 8) kf[(d0 + 1) & 1] = *(const LAS bf16x8*)(kp + (d0 + 1) * 1024);
              __builtin_amdgcn_s_setprio(1);
              sc = MFMA32(kf[d0 & 1], qf[d0], sc);
              __builtin_amdgcn_s_setprio(0);
              __builtin_amdgcn_sched_barrier(0); } }
        if (t >= 4 * qb) {
#pragma unroll
            for (int r = 0; r < 16; ++r) { const int kv = 32 * t + crow(r, hi); if (kv > qabs) sc[r] = -1e30f; }
        }
        float mx = fmaxf(fmaxf(sc[0], sc[1]), fmaxf(sc[2], sc[3]));
#pragma unroll
        for (int r = 4; r < 16; r += 4) mx = fmaxf(mx, fmaxf(fmaxf(sc[r], sc[r + 1]), fmaxf(sc[r + 2], sc[r + 3])));
        { auto rr = __builtin_amdgcn_permlane32_swap(__float_as_uint(mx), __float_as_uint(mx), false, false); mx = fmaxf(__uint_as_float(rr[0]), __uint_as_float(rr[1])); }
        float ls = 0.f;
        const bool resc = __any(mx > mhat + 8.0f);
        const float mnew = resc ? fmaxf(mhat, mx) : mhat, alpha = __builtin_amdgcn_exp2f(mhat - mnew);
        mhat = mnew;
        if (t == 0) {
#pragma unroll
            for (int r = 0; r < 16; ++r) { sc[r] = __builtin_amdgcn_exp2f(sc[r] - mhat); ls += sc[r]; }
        } else {
            s16x4 vl[3], vh[3];
#pragma unroll
            for (int i = 0; i < 2; ++i) { vl[i] = trrd(DA_VADDR(i)); vh[i] = trrd(DA_VADDR(i) + 4096); }
            __builtin_amdgcn_sched_barrier(0);
#pragma unroll
            for (int i = 0; i < 16; ++i) {
                if (i + 2 < 16) { vl[(i + 2) % 3] = trrd(DA_VADDR(i + 2)); vh[(i + 2) % 3] = trrd(DA_VADDR(i + 2) + 4096); }
                __builtin_amdgcn_s_setprio(1);
                if (VAR != 2) O[i & 7] = MFMA32(i < 8 ? pa0 : pa1, cat4(vl[i % 3], vh[i % 3]), O[i & 7]);
                __builtin_amdgcn_s_setprio(0);
                sc[i] = __builtin_amdgcn_exp2f(sc[i] - mhat); ls += sc[i];
                __builtin_amdgcn_sched_barrier(0);
            }
        }
        if (resc) {
            wscr[r32] = alpha;
#pragma unroll
            for (int gq = 0; gq < 4; ++gq) { const f32x4 a4 = *(const LAS f32x4*)(wscr + 8 * gq + 4 * hi);
#pragma unroll
                for (int n = 0; n < 8; ++n)
#pragma unroll
                    for (int e = 0; e < 4; ++e) O[n][4 * gq + e] *= a4[e]; }
        }
        lsum *= alpha;
        lsum += ls;
        pa0 = pack8(sc[0], sc[1], sc[2], sc[3], sc[4], sc[5], sc[6], sc[7]); pa1 = pack8(sc[8], sc[9], sc[10], sc[11], sc[12], sc[13], sc[14], sc[15]);
        slp = sl; sl = (sl == 2 ? 0 : sl + 1);
    }
    pv_plain(O, lds + VBASE + slp * VSLOT, vb0, pa0, pa1);
    lsum += __shfl_xor(lsum, 32);
    { const float f = (map == 0 ? 1.0f : lam) / lsum;
      wscr[r32] = f;
#pragma unroll
      for (int gq = 0; gq < 4; ++gq) { const f32x4 a4 = *(const LAS f32x4*)(wscr + 8 * gq + 4 * hi);
#pragma unroll
          for (int n = 0; n < 8; ++n)
#pragma unroll
              for (int e = 0; e < 4; ++e) O[n][4 * gq + e] *= a4[e]; } }
    __syncthreads();
    LAS float* xch = (LAS float*)(lds + g * 32768);
    if (map == 1) {
#pragma unroll
        for (int n = 0; n < 8; ++n)
#pragma unroll
            for (int r = 0; r < 16; ++r) xch[(n * 16 + r) * 64 + lane] = O[n][r];
    }
    __syncthreads();
    if (map == 0 && (VAR == 0 || lsum == 12345.678f)) {
        float ssq[16];
#pragma unroll
        for (int r = 0; r < 16; ++r) ssq[r] = 0.f;
#pragma unroll
        for (int n = 0; n < 8; ++n)
#pragma unroll
            for (int r = 0; r < 16; ++r) { O[n][r] -= xch[(n * 16 + r) * 64 + lane]; ssq[r] += O[n][r] * O[n][r]; }
#pragma unroll
        for (int r = 0; r < 16; ++r) {
#pragma unroll
            for (int o = 1; o < 32; o <<= 1) ssq[r] += __shfl_xor(ssq[r], o);
            ssq[r] = osc / sqrtf(ssq[r] * (1.0f / 256.0f) + 1e-6f);
        }
        const size_t tok0 = (size_t)b * 8192 + qrow0;
#pragma unroll
        for (int n = 0; n < 8; ++n) { const float sg = subg[32 * n + r32];
#pragma unroll
            for (int r = 0; r < 16; ++r) xch[crow(r, hi) * 256 + 32 * n + r32] = O[n][r] * ssq[r] * sg; }
        int lane2 = threadIdx.x & 63; asm volatile("" : "+v"(lane2));
#pragma unroll 4
        for (int i = 0; i < 16; ++i) { const int row = (lane2 >> 5) + 2 * i, c = lane2 & 31;
            const f32x4 v0 = *(const LAS f32x4*)(xch + row * 256 + c * 8), v1 = *(const LAS f32x4*)(xch + row * 256 + c * 8 + 4);
            const size_t idx = (tok0 + row) * 2048 + h * 256 + c * 8;
            const u32x4 gg = *(const u32x4*)(G + idx);
            u32x4 w; w.x = cvtpk(v0[0] * bflo(gg.x), v0[1] * bfhi(gg.x)); w.y = cvtpk(v0[2] * bflo(gg.y), v0[3] * bfhi(gg.y)); w.z = cvtpk(v1[0] * bflo(gg.z), v1[1] * bfhi(gg.z)); w.w = cvtpk(v1[2] * bflo(gg.w), v1[3] * bfhi(gg.w));
            *(u32x4*)(AO + idx) = w; }
    }
    __syncthreads();
}
#undef DA_VADDR
}

namespace swa {
__device__ __forceinline__ void unit(LAS unsigned char* lds, LAS float* wscr, const bf16_t* Q, const bf16_t* K, const bf16_t* V, const bf16_t* G, bf16_t* AO, const float* sinks, int b, int kvh, int nb) {
    const int tid = threadIdx.x, lane = tid & 63, wid = __builtin_amdgcn_readfirstlane(tid >> 6), r32 = lane & 31, hi = lane >> 5;
    const int q4 = (lane & 15) >> 2, p4 = lane & 3, blk = (lane >> 4) & 1;
    LAS unsigned char* Ks = lds; LAS unsigned char* Vs = lds + 32768;
    const bf16_t* Kg = K + (size_t)(b * 4 + kvh) * 8192 * 64; const bf16_t* Vg = V + (size_t)(b * 4 + kvh) * 8192 * 64;
#pragma unroll
    for (int i = 0; i < 4; ++i) { const int id = tid + 512 * i, row = id >> 3, ch = id & 7, kabs = 128 * (nb - 1) + row;
        u32x4 kv = (u32x4){0u, 0u, 0u, 0u}, vv = (u32x4){0u, 0u, 0u, 0u};
        if (kabs >= 0) { kv = *(const u32x4*)(Kg + (size_t)kabs * 64 + ch * 8); vv = *(const u32x4*)(Vg + (size_t)kabs * 64 + ch * 8); }
        *(LAS u32x4*)(Ks + off128k(row, ch)) = kv; *(LAS u32x4*)(Vs + off128v(row, ch)) = vv; }
    __syncthreads();
    const int head = kvh * 8 + wid;
    const float sk = sinks[head] * LOG2E;
    const bf16_t* Qh = Q + ((size_t)(b * 32 + head) * 8192 + nb * 128) * 64;
    for (int i = 0; i < 4; ++i) {
        bf16x8 qf[4];
#pragma unroll
        for (int d0 = 0; d0 < 4; ++d0) qf[d0] = *(const bf16x8*)(Qh + (size_t)(32 * i + r32) * 64 + d0 * 16 + hi * 8);
        f32x16 sc[5];
        const int qq = 128 + 32 * i + r32;
        float mx = sk;
#pragma unroll
        for (int jj = 0; jj < 5; ++jj) { const int j = i + jj;
#pragma unroll
            for (int r = 0; r < 16; ++r) sc[jj][r] = 0.f;
#pragma unroll
            for (int d0 = 0; d0 < 4; ++d0) { const bf16x8 kf = *(const LAS bf16x8*)(Ks + off128k(32 * j + r32, 2 * d0 + hi)); sc[jj] = MFMA32(kf, qf[d0], sc[jj]); }
            if (jj == 0 || jj == 4 || nb == 0) {
#pragma unroll
                for (int r = 0; r < 16; ++r) { const int kk = 32 * j + crow(r, hi); const bool ok = (kk <= qq) && (qq - kk < 128) && (nb > 0 || kk >= 128);
                    sc[jj][r] = ok ? sc[jj][r] : -1e30f; }
            }
#pragma unroll
            for (int r = 0; r < 16; ++r) mx = fmaxf(mx, sc[jj][r]);
        }
        mx = fmaxf(mx, __shfl_xor(mx, 32));
        float ls = 0.f;
#pragma unroll
        for (int jj = 0; jj < 5; ++jj)
#pragma unroll
            for (int r = 0; r < 16; ++r) { sc[jj][r] = __builtin_amdgcn_exp2f(sc[jj][r] - mx); ls += sc[jj][r]; }
        ls += __shfl_xor(ls, 32);
        ls += __builtin_amdgcn_exp2f(sk - mx);
        f32x16 O[2];
#pragma unroll
        for (int n = 0; n < 2; ++n)
#pragma unroll
            for (int r = 0; r < 16; ++r) O[n][r] = 0.f;
#pragma unroll
        for (int jj = 0; jj < 5; ++jj)
#pragma unroll
            for (int c = 0; c < 2; ++c) {
                const bf16x8 pa = pack8(sc[jj][8 * c + 0], sc[jj][8 * c + 1], sc[jj][8 * c + 2], sc[jj][8 * c + 3], sc[jj][8 * c + 4], sc[jj][8 * c + 5], sc[jj][8 * c + 6], sc[jj][8 * c + 7]);
                const int vr = 32 * (i + jj) + 16 * c + 4 * hi + q4;
#pragma unroll
                for (int n = 0; n < 2; ++n) { const int ch = 4 * n + 2 * blk + (p4 >> 1);
                    const s16x4 lo = trrd(Vs + off128v(vr, ch) + 8 * (p4 & 1)), hh = trrd(Vs + off128v(vr + 8, ch) + 8 * (p4 & 1));
                    O[n] = MFMA32(pa, cat4(lo, hh), O[n]); }
            }
        wscr[r32] = 1.0f / ls;
        f32x4 a4[4];
#pragma unroll
        for (int gq = 0; gq < 4; ++gq) a4[gq] = *(const LAS f32x4*)(wscr + 8 * gq + 4 * hi);
        const size_t tok0 = (size_t)b * 8192 + nb * 128 + 32 * i;
        LAS float* stg = (LAS float*)(lds + 65536 + wid * 8192);
#pragma unroll
        for (int n = 0; n < 2; ++n)
#pragma unroll
            for (int r = 0; r < 16; ++r) stg[crow(r, hi) * 64 + 32 * n + r32] = O[n][r] * a4[r >> 2][r & 3];
#pragma unroll
        for (int k4 = 0; k4 < 4; ++k4) { const int row = (lane >> 3) + 8 * k4, c = lane & 7;
            const f32x4 v0 = *(const LAS f32x4*)(stg + row * 64 + c * 8), v1 = *(const LAS f32x4*)(stg + row * 64 + c * 8 + 4);
            const size_t idx = (tok0 + row) * 2048 + head * 64 + c * 8;
            const u32x4 gg = *(const u32x4*)(G + idx);
            u32x4 w; w.x = cvtpk(v0[0] * bflo(gg.x), v0[1] * bfhi(gg.x)); w.y = cvtpk(v0[2] * bflo(gg.y), v0[3] * bfhi(gg.y)); w.z = cvtpk(v1[0] * bflo(gg.z), v1[1] * bfhi(gg.z)); w.w = cvtpk(v1[2] * bflo(gg.w), v1[3] * bfhi(gg.w));
            *(u32x4*)(AO + idx) = w; }
    }
    __syncthreads();
}
}

namespace ml {
__device__ __forceinline__ void gate_carry(float* sc, int bh, int lane) {
    const float a0 = sc[SC_BLC + bh * 128 + lane], a1 = sc[SC_BLC + bh * 128 + 64 + lane], c0 = sc[SC_CML + bh * 128 + lane], c1 = sc[SC_CML + bh * 128 + 64 + lane];
    float m = 0.f, segsum = 0.f, mstart = 0.f;
    for (int c = 0; c < 128; ++c) {
        const int l = c & 63;
        const float bL = __uint_as_float(__builtin_amdgcn_readlane(__float_as_uint(c < 64 ? a0 : a1), l)), cmL = __uint_as_float(__builtin_amdgcn_readlane(__float_as_uint(c < 64 ? c0 : c1), l));
        if (lane == 0) sc[SC_MC + bh * 129 + c] = m;
        const float mnew = bL + fmaxf(m, cmL);
        segsum += bL;
        if ((c & 7) == 7) { if (lane == 0) sc[SC_SD + bh * 16 + (c >> 3)] = expf(segsum + mstart - mnew); segsum = 0.f; mstart = mnew; }
        m = mnew;
    }
    if (lane == 0) sc[SC_MC + bh * 129 + 128] = m;
}
constexpr int L_Q = 0, L_K = 16384, L_V = 32768, L_VW = 65536, L_A = 98304, L_SC = 106496, L_H = 110592, HROW = 520;
__device__ __forceinline__ void store_h(const LAS unsigned char* lds, bf16_t* hs0, int tid) {
#pragma unroll
    for (int i = 0; i < 4; ++i) { const int id = tid + 512 * i, row = id >> 5, c16 = id & 31;
        const u32x2 lo = *(const LAS u32x2*)(lds + L_H + row * HROW + c16 * 16), hi2 = *(const LAS u32x2*)(lds + L_H + row * HROW + c16 * 16 + 8);
        *(u32x4*)(hs0 + (size_t)row * 2048 + c16 * 8) = (u32x4){lo.x, lo.y, hi2.x, hi2.y}; }
}
template <bool FULL, int VAR = 0> __device__ __forceinline__ void seg_pass(LAS unsigned char* lds, const bf16_t* Q, const bf16_t* K, const bf16_t* V, const float* sc, float* Est, float* En, bf16_t* HS, int bh, int seg) {
    int tid = threadIdx.x; asm volatile("" : "+v"(tid));
    const int lane = tid & 63, wid = __builtin_amdgcn_readfirstlane(tid >> 6), r32 = lane & 31, hi = lane >> 5;
    const int q4 = (lane & 15) >> 2, p4 = lane & 3, blk = (lane >> 4) & 1;
    const int b = bh >> 3, h = bh & 7;
    LAS float* sbl = (LAS float*)(lds + L_SC); LAS float* sii = sbl + 64; LAS float* smt = sbl + 128; LAS float* swk = sbl + 192; LAS float* rows = sbl + 256; LAS float* nq = sbl + 384; LAS float* nvec = sbl + 448;
    const bf16_t* Qg = Q + (size_t)bh * 8192 * 128; const bf16_t* Kg = K + (size_t)bh * 8192 * 128; const bf16_t* Vg = V + (size_t)bh * 8192 * 256;
    const float* gbl = sc + SC_BL + bh * 8192; const float* gii = sc + SC_II + bh * 8192; const float* gmt = sc + SC_MT + bh * 8192; const float* gmc = sc + SC_MC + bh * 129;
    f32x16 CT[4];
    float* Eb = Est + (size_t)(bh * 16 + seg) * 32768 + (size_t)(wid * 4) * 1024;
    if (FULL) {
        const float* e = Eb + lane;
#pragma unroll
        for (int dt = 0; dt < 4; ++dt) {
#pragma unroll
            for (int r = 0; r < 16; ++r) CT[dt][r] = e[r * 64];
            e += 1024; asm volatile("" : "+v"(e)); }
        if (tid < 128) nvec[tid] = En[(size_t)(bh * 16 + seg) * 128 + tid];
    } else {
#pragma unroll
        for (int dt = 0; dt < 4; ++dt)
#pragma unroll
            for (int r = 0; r < 16; ++r) CT[dt][r] = 0.f;
        if (tid < 128) nvec[tid] = 0.f;
    }
    for (int cc = 0; cc < 8; ++cc) {
        const int c = seg * 8 + cc, t0 = 64 * c;
        const float m_in = gmc[c], m_out = gmc[c + 1], bL = gbl[t0 + 63];
        __syncthreads();
        if (FULL && cc > 0) store_h(lds, HS + ((size_t)b * 8192 + t0 - 64) * 2048 + h * 256, tid);
        if (VAR != 2 || cc == 0) {
#pragma unroll
        for (int i = 0; i < 2; ++i) { const int id = tid + 512 * i, row = id >> 4, ch = id & 15;
            if (FULL) *(LAS u32x4*)(lds + L_Q + off256(row, ch)) = *(const u32x4*)(Qg + (size_t)(t0 + row) * 128 + ch * 8);
            *(LAS u32x4*)(lds + L_K + off256(row, ch)) = *(const u32x4*)(Kg + (size_t)(t0 + row) * 128 + ch * 8); }
#pragma unroll
        for (int i = 0; i < 4; ++i) { const int id = lane + 64 * i, row = id >> 2, cq = id & 3;
            const u32x4 vv = *(const u32x4*)(Vg + (size_t)(t0 + row) * 256 + wid * 32 + cq * 8);
            const float wk = __expf(bL - gbl[t0 + row] + gii[t0 + row] - m_out);
            u32x4 vw; vw.x = cvtpk(bflo(vv.x) * wk, bfhi(vv.x) * wk); vw.y = cvtpk(bflo(vv.y) * wk, bfhi(vv.y) * wk); vw.z = cvtpk(bflo(vv.z) * wk, bfhi(vv.z) * wk); vw.w = cvtpk(bflo(vv.w) * wk, bfhi(vv.w) * wk);
            if (FULL) *(LAS u32x4*)(lds + L_V + off512(row, 4 * wid + cq)) = vv;
            *(LAS u32x4*)(lds + L_VW + off512(row, 4 * wid + cq)) = vw; }
        if (tid < 64) { const float bl_ = gbl[t0 + tid], ii_ = gii[t0 + tid]; sbl[tid] = bl_; sii[tid] = ii_; smt[tid] = bl_ + fmaxf(m_in, gmt[t0 + tid]); swk[tid] = __expf(bL - bl_ + ii_ - m_out); }
        }
        __syncthreads();
        __builtin_amdgcn_sched_barrier(0);
        if (FULL) {
            if (wid < 4) {
                const int st = wid >> 1, tt = wid & 1, t = 32 * tt + r32;
                f32x16 s;
#pragma unroll
                for (int r = 0; r < 16; ++r) s[r] = 0.f;
                if (!(st == 1 && tt == 0)) {
#pragma unroll
                    for (int d0 = 0; d0 < 8; ++d0) { const bf16x8 kf = *(const LAS bf16x8*)(lds + L_K + off256(32 * st + r32, 2 * d0 + hi)); const bf16x8 qv = *(const LAS bf16x8*)(lds + L_Q + off256(t, 2 * d0 + hi)); s = MFMA32(kf, qv, s); }
                }
                const float sat = sbl[t] - smt[t];
                float rs = 0.f;
#pragma unroll
                for (int gq = 0; gq < 4; ++gq) { const int s0 = 32 * st + 8 * gq + 4 * hi;
                    const f32x4 bi = *(const LAS f32x4*)(sii + s0), bb = *(const LAS f32x4*)(sbl + s0);
                    float a[4];
#pragma unroll
                    for (int e = 0; e < 4; ++e) { const float w = (s0 + e <= t) ? __expf(sat + bi[e] - bb[e]) : 0.f; a[e] = s[4 * gq + e] * w; rs += a[e]; }
                    u32x2 pk; pk.x = cvtpk(a[0], a[1]); pk.y = cvtpk(a[2], a[3]);
                    *(LAS u32x2*)(lds + L_A + off128k(t, 4 * st + gq) + 8 * hi) = pk; }
                rs += __shfl_xor(rs, 32);
                if (hi == 0) rows[st * 64 + t] = rs;
            } else {
                const int idx = tid - 256, t = idx >> 2, part = idx & 3; float p = 0.f;
#pragma unroll
                for (int c4 = 0; c4 < 4; ++c4) { const u32x4 qv = *(const LAS u32x4*)(lds + L_Q + off256(t, 4 * part + c4)); const LAS float* nv = nvec + 32 * part + 8 * c4;
                    p += bflo(qv.x) * nv[0] + bfhi(qv.x) * nv[1] + bflo(qv.y) * nv[2] + bfhi(qv.y) * nv[3] + bflo(qv.z) * nv[4] + bfhi(qv.z) * nv[5] + bflo(qv.w) * nv[6] + bfhi(qv.w) * nv[7]; }
                p += __shfl_xor(p, 1); p += __shfl_xor(p, 2);
                if (part == 0) nq[t] = p;
            }
            __syncthreads();
            __builtin_amdgcn_sched_barrier(0);
#pragma unroll 1
            for (int tt = 0; tt < 2; ++tt) {
                const int t = 32 * tt + r32;
                f32x16 acc;
#pragma unroll
                for (int r = 0; r < 16; ++r) acc[r] = 0.f;
#pragma unroll
                for (int dt = 0; dt < 4; ++dt)
#pragma unroll
                    for (int c2 = 0; c2 < 2; ++c2) {
                        const bf16x8 A = pack8(CT[dt][8 * c2 + 0], CT[dt][8 * c2 + 1], CT[dt][8 * c2 + 2], CT[dt][8 * c2 + 3], CT[dt][8 * c2 + 4], CT[dt][8 * c2 + 5], CT[dt][8 * c2 + 6], CT[dt][8 * c2 + 7]);
                        const s16x4 lo = *(const LAS s16x4*)(lds + L_Q + off256(t, 4 * dt + 2 * c2) + 8 * hi), hh = *(const LAS s16x4*)(lds + L_Q + off256(t, 4 * dt + 2 * c2 + 1) + 8 * hi);
                        acc = MFMA32(A, cat4(lo, hh), acc);
                    }
                const float wi = __expf(sbl[t] + m_in - smt[t]);
#pragma unroll
                for (int r = 0; r < 16; ++r) acc[r] *= wi;
#pragma unroll 1
                for (int cs = 0; cs < 4; ++cs) { const int vr = 16 * cs + 8 * hi + q4, ch = 4 * wid + 2 * blk + (p4 >> 1);
                    const s16x4 lo = trrd(lds + L_V + off512(vr, ch) + 8 * (p4 & 1)), hh = trrd(lds + L_V + off512(vr + 4, ch) + 8 * (p4 & 1));
                    const bf16x8 B = *(const LAS bf16x8*)(lds + L_A + off128k(t, 2 * cs + hi));
                    acc = MFMA32(cat4(lo, hh), B, acc); }
                const float dn = rows[t] + rows[64 + t] + wi * nq[t];
                const float inv = 1.0f / fmaxf(fabsf(dn), __expf(-smt[t]));
#pragma unroll
                for (int gq = 0; gq < 4; ++gq) { u32x2 pk; pk.x = cvtpk(acc[4 * gq] * inv, acc[4 * gq + 1] * inv); pk.y = cvtpk(acc[4 * gq + 2] * inv, acc[4 * gq + 3] * inv);
                    *(LAS u32x2*)(lds + L_H + t * HROW + (wid * 32 + 8 * gq + 4 * hi) * 2) = pk; }
            }
        }
        __builtin_amdgcn_sched_barrier(0);
        const float decay = __expf(bL + m_in - m_out);
#pragma unroll
        for (int dt = 0; dt < 4; ++dt)
#pragma unroll
            for (int r = 0; r < 16; ++r) CT[dt][r] *= decay;
#pragma unroll 1
        for (int cs = 0; cs < 4; ++cs) { const int vr = 16 * cs + 8 * hi + q4, chv = 4 * wid + 2 * blk + (p4 >> 1);
            const s16x4 bl0 = trrd(lds + L_VW + off512(vr, chv) + 8 * (p4 & 1)), bh0 = trrd(lds + L_VW + off512(vr + 4, chv) + 8 * (p4 & 1));
            const bf16x8 B = cat4(bl0, bh0);
#pragma unroll
            for (int dt = 0; dt < 4; ++dt) { const int chk = 4 * dt + 2 * blk + (p4 >> 1);
                const s16x4 al = trrd(lds + L_K + off256(vr, chk) + 8 * (p4 & 1)), ah = trrd(lds + L_K + off256(vr + 4, chk) + 8 * (p4 & 1));
                CT[dt] = MFMA32(cat4(al, ah), B, CT[dt]); } }
        if (wid >= 4) {
            const int idx = tid - 256, d = idx >> 1, half = idx & 1; float p = 0.f;
#pragma unroll 8
            for (int s = 0; s < 32; ++s) { const int sr = 32 * half + s; p += swk[sr] * bf2f(*(const LAS unsigned short*)(lds + L_K + off256(sr, d >> 3) + 2 * (d & 7))); }
            p += __shfl_xor(p, 1);
            if (half == 0) nvec[d] = decay * nvec[d] + p;
        }
    }
    if (FULL) { __syncthreads(); store_h(lds, HS + ((size_t)b * 8192 + (seg * 8 + 7) * 64) * 2048 + h * 256, tid); }
    if (!FULL) {
#pragma unroll
        for (int dt = 0; dt < 4; ++dt)
#pragma unroll
            for (int r = 0; r < 16; ++r) Eb[(dt * 16 + r) * 64 + lane] = CT[dt][r];
        __syncthreads();
        if (tid < 128) En[(size_t)(bh * 16 + seg) * 128 + tid] = nvec[tid];
    }
    __syncthreads();
}
__device__ __forceinline__ void seg_scan(float* Est, float* En, const float* sc, int gtid, int ngt) {
    for (int e = gtid; e < 16 * (32768 + 128); e += ngt) {
        const int bh = e / (32768 + 128), i = e - bh * (32768 + 128);
        float* p = (i < 32768) ? Est + (size_t)bh * 16 * 32768 + i : En + (size_t)bh * 16 * 128 + (i - 32768);
        const size_t stride = (i < 32768) ? 32768 : 128;
        float run = 0.f;
        for (int sg = 0; sg < 16; ++sg) { const float tmp = p[sg * stride]; p[sg * stride] = run; run = sc[SC_SD + bh * 16 + sg] * run + tmp; }
    }
}
__device__ __forceinline__ void finalize(bf16_t* HS, const bf16_t* SO, const bf16_t* SG, const float* ng, int gw, int NGW, int lane) {
    const f32x4 gv = ((const f32x4*)ng)[lane];
    for (int row = gw; row < TOK; row += NGW) {
        u32x2* hp = (u32x2*)(HS + (size_t)row * DM) + lane; const u32x2* op = (const u32x2*)(SO + (size_t)row * DM) + lane; const u32x2* gp = (const u32x2*)(SG + (size_t)row * DM) + lane;
#pragma unroll
        for (int j = 0; j < 8; ++j) { const u32x2 hv = hp[64 * j], ov = op[64 * j], sg = gp[64 * j];
            const float x0 = bflo(hv.x), x1 = bfhi(hv.x), x2 = bflo(hv.y), x3 = bfhi(hv.y);
            const float r = 1.0f / sqrtf(wave_sum((x0 * x0 + x1 * x1) + (x2 * x2 + x3 * x3)) * (1.0f / 256.0f) + 1e-6f);
            u32x2 w; w.x = cvtpk(x0 * r * gv.x * bflo(ov.x) * bflo(sg.x), x1 * r * gv.y * bfhi(ov.x) * bfhi(sg.x)); w.y = cvtpk(x2 * r * gv.z * bflo(ov.y) * bflo(sg.y), x3 * r * gv.w * bfhi(ov.y) * bfhi(sg.y));
            hp[64 * j] = w; }
    }
}
}
#define XB_TMO      128
#define XB_XCNT(j)  (256  + 64 * (j))
#define XB_XSUB(j)  (1280 + 64 * (j))
#define XB_XGEN(j)  (2304 + 64 * (j))
#define XB_TOP      3328
#define XB_TOPGEN   3392
#define XCD_BAR_WORDS 3456
#define XB_SPIN_CAP (1u << 18)

__device__ __forceinline__ unsigned xb_ld(unsigned* p)              { return __hip_atomic_load(p, __ATOMIC_RELAXED, __HIP_MEMORY_SCOPE_AGENT); }
__device__ __forceinline__ unsigned xb_add(unsigned* p, unsigned v) { return __hip_atomic_fetch_add(p, v, __ATOMIC_RELAXED, __HIP_MEMORY_SCOPE_AGENT); }
__device__ __forceinline__ unsigned xb_xcc_id() { return (unsigned)__builtin_amdgcn_s_getreg((3 << 11) | 20) & 0xFu; }
#define XB_SPIN(cond, bar) do { unsigned _sp = 0; while (cond) { __builtin_amdgcn_s_sleep(1); \
    if ((++_sp & 255u) == 0u) { if (xb_ld(&(bar)[XB_TMO])) break; if (_sp > XB_SPIN_CAP) { atomicAdd(&(bar)[XB_TMO], 1u); break; } } } } while (0)

struct XcdBarrier {
    unsigned* bar; unsigned x;
    volatile LAS unsigned* st;
};

__device__ __forceinline__ XcdBarrier xcd_barrier_post(unsigned* bar, volatile LAS unsigned* st) {
    XcdBarrier b; b.bar = bar; b.x = xb_xcc_id(); b.st = st;
    if (threadIdx.x == 0) (void)xb_add(&bar[XB_XCNT(b.x)], 1u);
    return b;
}
__device__ __forceinline__ void xcd_barrier_complete(unsigned* bar, unsigned x, unsigned& nloc, unsigned& nx) {
    const unsigned G = gridDim.x * gridDim.y * gridDim.z;
    unsigned sum, cnt, mine, sp = 0u;
    for (;;) {
        sum = 0u; cnt = 0u; mine = 0u;
#pragma unroll
        for (unsigned j = 0; j < 16; ++j) { const unsigned c = xb_ld(&bar[XB_XCNT(j)]); sum += c; cnt += (c > 0u) ? 1u : 0u; mine = (j == x) ? c : mine; }
        if (sum == G) break;
        __builtin_amdgcn_s_sleep(1);
        if ((++sp & 255u) == 0u) { if (xb_ld(&bar[XB_TMO])) break; if (sp > XB_SPIN_CAP) { atomicAdd(&bar[XB_TMO], 1u); break; } }
    }
    nloc = mine > 0u ? mine : 1u; nx = cnt > 0u ? cnt : 1u;
}

__device__ __forceinline__ void xcd_barrier(const XcdBarrier& b) {
    asm volatile("s_waitcnt vmcnt(0)" ::: "memory");
    __syncthreads();
    if (threadIdx.x == 0) {
        unsigned* bar = b.bar;
        __builtin_amdgcn_s_waitcnt(0);
        unsigned nloc = b.st[0], nx = b.st[1];
        if (nloc == 0u) { xcd_barrier_complete(bar, b.x, nloc, nx); b.st[0] = nloc; b.st[1] = nx; }
        const unsigned old = xb_add(&bar[XB_XSUB(b.x)], 1u);
        const unsigned gen = old / nloc;
        if (old + 1u == (gen + 1u) * nloc) {
            __builtin_amdgcn_fence(__ATOMIC_RELEASE, "agent");
            asm volatile("s_waitcnt vmcnt(0)" ::: "memory");
            const unsigned og = xb_add(&bar[XB_TOP], 1u);
            const unsigned tg = og / nx;
            if (og + 1u == (tg + 1u) * nx) xb_add(&bar[XB_TOPGEN], 1u);
            else XB_SPIN(xb_ld(&bar[XB_TOPGEN]) == tg, bar);
            __builtin_amdgcn_fence(__ATOMIC_ACQUIRE, "agent");
            xb_add(&bar[XB_XGEN(b.x)], 1u);
            asm volatile("s_waitcnt vmcnt(0)" ::: "memory");
        } else {
            XB_SPIN(xb_ld(&bar[XB_XGEN(b.x)]) == gen, bar);
            __builtin_amdgcn_fence(__ATOMIC_ACQUIRE, "agent");
            asm volatile("s_waitcnt vmcnt(0)" ::: "memory");
        }
    }
    __syncthreads();
}

struct Args {
    const float* x; const int* pos; const float* norm_g; const float* final_g;
    const float* da_w_in; const float* da_w_out; const float* da_lambda; const float* da_subln;
    const float* sw_w_in; const float* sw_w_out; const float* sw_sinks;
    const float* ml_w_in; const float* ml_b_gates; const float* ml_w_out; const float* ml_norm_g;
    float* out; unsigned char* ws; int ph_lo, ph_hi;
};
#ifndef PROBE_EXTRA
#define PROBE_EXTRA 0
#endif
constexpr int N_PHASES = 20 + PROBE_EXTRA;
#ifndef MK_LAUNCHES
#define MK_LAUNCHES 1
#endif

__device__ __forceinline__ float da_lambda_full(const float* lam, float lambda_init, int lane) {
    float a = lam[lane] * lam[128 + lane] + lam[64 + lane] * lam[128 + 64 + lane];
    float c = lam[256 + lane] * lam[384 + lane] + lam[256 + 64 + lane] * lam[384 + 64 + lane];
    a = wave_sum(a); c = wave_sum(c);
    return expf(a) - expf(c) + lambda_init;
}

__global__ void __launch_bounds__(512, 2) hybrid_fwd(Args args) {
    extern __shared__ __attribute__((aligned(16))) unsigned char lds_raw[];
    LAS unsigned char* lds = (LAS unsigned char*)lds_raw;
    cg::grid_group grid = cg::this_grid();
    const int tid0 = threadIdx.x, wave = __builtin_amdgcn_readfirstlane(tid0 >> 6);
    const int G = gridDim.x, bx = blockIdx.x, vcu = (G % 8 == 0) ? (bx % 8) * (G / 8) + bx / 8 : bx;
    const int gw = vcu * NWAVES + wave, NGW = G * NWAVES, ngt = G * 512;
    unsigned char* ws = args.ws;
    bf16_t* HN = (bf16_t*)(ws + WS_HN); bf16_t* ACT = (bf16_t*)(ws + WS_ACT);
    float* SCN = (float*)(ws + WS_SCAN); float* GIF = (float*)(ws + WS_GIF);
    LAS float* wscr = (LAS float*)(lds + MISC_OFF) + wave * 64;
    (void)gw; (void)ngt;
    const int lo = args.ph_lo, hi = args.ph_hi;
    volatile LAS unsigned* xb_st = (volatile LAS unsigned*)(lds + LDS_BYTES - 16);
    if (tid0 < 2) xb_st[tid0] = 0u;
    __syncthreads();
    XcdBarrier xbar = xcd_barrier_post((unsigned*)(ws + 4096), xb_st);
    if (args.ph_lo == 0x7fffffff) grid.sync();
    int ph = 0;
#ifndef PROBE_MLV
#define PROBE_MLV 0
#endif
#ifndef PROBE_REP
#define PROBE_REP 0u
#endif
#ifndef PH_MASK
#define PH_MASK 0xFFFFFFFu
#endif
#define PHASE_BEGIN if (((PH_MASK >> ph) & 1u) && ph >= lo && ph < hi) { int tid = tid0; asm volatile("" : "+v"(tid)); const int lane = tid & 63, gtid = vcu * 512 + tid; (void)lane; (void)gtid;
#define PHASE_END   if (ph + 1 < hi) xcd_barrier(xbar); } ++ph;

    PHASE_BEGIN
        LAS float* scr = (LAS float*)(lds + wave * 16640);
        { constexpr int I_IN = 32 * 128, I_OUT = 32 * 32, I_SW = 32 * 72;
          const CvMat ma{args.da_w_in, (bf16_t*)(ws + WS_W_DA0_IN), 8192, 8192, 1}, mb{args.sw_w_in, (bf16_t*)(ws + WS_W_SW_IN), 4608, 4608, 2},
                      mc{args.da_w_out, (bf16_t*)(ws + WS_W_DA0_OUT), 2048, 2048, 0}, md{args.sw_w_out, (bf16_t*)(ws + WS_W_SW_OUT), 2048, 2048, 0};
          convert_set(ma, mb, mc, md, I_IN, I_SW, I_OUT, I_OUT, gw, NGW, scr, lane); }
        rope_table(args.pos, 64, (float*)(ws + WS_ROPEA_C), (float*)(ws + WS_ROPEA_S), gtid, ngt);
        rope_table(args.pos, 32, (float*)(ws + WS_ROPEB_C), (float*)(ws + WS_ROPEB_S), gtid, ngt);
        norm_rows<false>(args.x, args.norm_g, HN, gw, NGW, lane, nullptr, nullptr, nullptr);
    PHASE_END
#ifdef PROBE_P0
    PHASE_BEGIN
        LAS float* scr = (LAS float*)(lds + wave * 16640);
        { constexpr int I_IN = 32 * 128, I_OUT = 32 * 32, I_SW = 32 * 72;
          const CvMat ma{args.da_w_in, (bf16_t*)(ws + WS_W_DA0_IN), 8192, 8192, 1}, mb{args.sw_w_in, (bf16_t*)(ws + WS_W_SW_IN), 4608, 4608, 2},
                      mc{args.da_w_out, (bf16_t*)(ws + WS_W_DA0_OUT), 2048, 2048, 0}, md{args.sw_w_out, (bf16_t*)(ws + WS_W_SW_OUT), 2048, 2048, 0};
          convert_set(ma, mb, mc, md, I_IN, I_SW, I_OUT, I_OUT, gw, NGW, scr, lane); }
        rope_table(args.pos, 64, (float*)(ws + WS_ROPEA_C), (float*)(ws + WS_ROPEA_S), gtid, ngt);
        rope_table(args.pos, 32, (float*)(ws + WS_ROPEB_C), (float*)(ws + WS_ROPEB_S), gtid, ngt);
        norm_rows<false>(args.x, args.norm_g, HN, gw, NGW, lane, nullptr, nullptr, nullptr);
    PHASE_END
#endif

#define GEMM_IN(KIND, WOFF, NCOLS, COST, SINT) GEMM_IN2(KIND, WOFF, NCOLS, COST, SINT, 0)
#define GEMM_IN2(KIND, WOFF, NCOLS, COST, SINT, SKIP) do { asm volatile("s_waitcnt vmcnt(0)" ::: "memory"); \
        pg8::Gemm g_{HN, (const bf16_t*)(ws + (WOFF)), TOK, (NCOLS), 2048}; pg8::StaticOrder S_; S_.init(TOK, (NCOLS), G, bx); \
        pg8::EpiProj E_{(KIND), ACT, (const float*)(ws + (COST)), (const float*)(ws + (SINT)), (SKIP)}; \
        pg8::gemm_phase<pg8::EpiProj, pg8::StaticOrder, true, true>(lds, g_, S_, E_); } while (0)
#define GEMM_OUT(WOFF, XIN) do { asm volatile("s_waitcnt vmcnt(0)" ::: "memory"); \
        pg8::Gemm g_{HN, (const bf16_t*)(ws + (WOFF)), TOK, 2048, 2048}; pg8::StaticOrder S_; S_.init(TOK, 2048, G, bx); \
        pg8::EpiRes E_{(XIN), args.out}; \
        pg8::gemm_phase<pg8::EpiRes, pg8::StaticOrder, true, true>(lds, g_, S_, E_); } while (0)
#define DA_ATTN(LAYER_J, LAMBDA_INIT, VARIANT) do { \
        const float lamf_ = da_lambda_full(args.da_lambda + (LAYER_J) * 512, (LAMBDA_INIT), lane); \
        for (int idx_ = vcu; idx_ < 1024; idx_ += G) { const int rnd_ = idx_ >> 8, w_ = idx_ & 255, bh_ = w_ >> 4, s_ = w_ & 15; \
            const int qb_ = rnd_ == 0 ? 63 - s_ : rnd_ == 1 ? 32 + s_ : rnd_ == 2 ? 31 - s_ : s_; \
            da::unit<VARIANT>(lds, wscr, ACT, ACT + 32 * pg8::ACT_MiB, ACT + 64 * pg8::ACT_MiB, ACT + 96 * pg8::ACT_MiB, HN, args.da_subln + (LAYER_J) * 256, lamf_, 1.0f - (LAMBDA_INIT), bh_ >> 3, bh_ & 7, qb_); } } while (0)

    PHASE_BEGIN GEMM_IN(0, WS_W_DA0_IN, 8192, WS_ROPEA_C, WS_ROPEA_S); PHASE_END
#ifdef PROBE_GEMM
    PHASE_BEGIN GEMM_IN2(0, WS_W_DA0_IN, 8192, WS_ROPEA_C, WS_ROPEA_S, PROBE_GEMM - 1); PHASE_END
#endif
    PHASE_BEGIN DA_ATTN(0, 0.2f, 0); PHASE_END
#ifdef PROBE_ATTN
    PHASE_BEGIN DA_ATTN(0, 0.2f, PROBE_ATTN); PHASE_END
#endif
    PHASE_BEGIN GEMM_OUT(WS_W_DA0_OUT, args.x); PHASE_END
    PHASE_BEGIN norm_rows<false>(args.out, args.norm_g + 2048, HN, gw, NGW, lane, nullptr, nullptr, nullptr); PHASE_END
#ifdef PROBE_NORM
    PHASE_BEGIN norm_rows<false>(args.out, args.norm_g + 2048, HN, gw, NGW, lane, nullptr, nullptr, nullptr); PHASE_END
#endif
#ifdef PROBE_SYNC
    for (int i_ = 0; i_ < 20; ++i_) grid.sync();
#endif
    PHASE_BEGIN
        GEMM_IN(1, WS_W_SW_IN, 4608, WS_ROPEB_C, WS_ROPEB_S);
        if (bx >= G / 2) {
            LAS float* scr = (LAS float*)(lds + wave * 16640);
            constexpr int I_IN = 32 * 128, I_OUT = 32 * 32;
            const int gw2 = (bx - G / 2) * NWAVES + wave, NGW2 = (G - G / 2) * NWAVES;
            const CvMat ma{args.ml_w_in, (bf16_t*)(ws + WS_W_ML_IN), 8208, 8192, 3}, mb{args.da_w_in + (size_t)2048 * 8192, (bf16_t*)(ws + WS_W_DA1_IN), 8192, 8192, 1},
                        mc{args.ml_w_out, (bf16_t*)(ws + WS_W_ML_OUT), 2048, 2048, 0}, md{args.da_w_out + (size_t)2048 * 2048, (bf16_t*)(ws + WS_W_DA1_OUT), 2048, 2048, 0};
            convert_set(ma, mb, mc, md, I_IN, I_IN, I_OUT, I_OUT, gw2, NGW2, scr, lane);
        }
    PHASE_END
    PHASE_BEGIN
        for (int u = vcu; u < 512; u += G) swa::unit(lds, wscr, ACT, ACT + 32 * pg8::ACT_MiB, ACT + 36 * pg8::ACT_MiB, ACT + 96 * pg8::ACT_MiB, HN, args.sw_sinks, u >> 8, (u >> 6) & 3, u & 63);
    PHASE_END
#ifdef PROBE_SWA
    PHASE_BEGIN
        for (int u = vcu; u < 512; u += G) swa::unit(lds, wscr, ACT, ACT + 32 * pg8::ACT_MiB, ACT + 36 * pg8::ACT_MiB, ACT + 96 * pg8::ACT_MiB, HN, args.sw_sinks, u >> 8, (u >> 6) & 3, u & 63);
    PHASE_END
#endif
    PHASE_BEGIN GEMM_OUT(WS_W_SW_OUT, args.out); PHASE_END
    PHASE_BEGIN
        { LAS float* wg = (LAS float*)lds;
          for (int i = tid; i < 2048 * 16; i += 512) { const int k = i >> 4, j = i & 15; wg[j * 2048 + k] = args.ml_w_in[(size_t)k * 8208 + 6144 + j]; }
          __syncthreads();
          for (int cidx = vcu; cidx < 256; cidx += G) norm_gif_chunk(args.out, args.norm_g + 2 * 2048, HN, wg, (LAS float*)(lds + MISC_OFF + 4096), args.ml_b_gates, SCN, cidx, wave, lane); }
    PHASE_END
    PHASE_BEGIN
        if (vcu < 16 && wave == 0) ml::gate_carry(SCN, vcu, lane);
        GEMM_IN(2, WS_W_ML_IN, 8192, WS_ROPEA_C, WS_ROPEA_S);
    PHASE_END
    PHASE_BEGIN
        for (int u = vcu; u < 256; u += G) ml::seg_pass<false>(lds, ACT, ACT + 16 * pg8::ACT_MiB, ACT + 32 * pg8::ACT_MiB, SCN, (float*)(ws + WS_MLSTATE), (float*)(ws + WS_MLN), HN, u >> 4, u & 15);
    PHASE_END
#if defined(PROBE_ML) && PROBE_ML != 3
    PHASE_BEGIN
        for (int u = vcu; u < 256; u += G) ml::seg_pass<false>(lds, ACT, ACT + 16 * pg8::ACT_MiB, ACT + 32 * pg8::ACT_MiB, SCN, (float*)(ws + WS_MLSTATE), (float*)(ws + WS_MLN), HN, u >> 4, u & 15);
    PHASE_END
#endif
    PHASE_BEGIN ml::seg_scan((float*)(ws + WS_MLSTATE), (float*)(ws + WS_MLN), SCN, gtid, ngt); PHASE_END
    PHASE_BEGIN
        for (int u = vcu; u < 256; u += G) ml::seg_pass<true>(lds, ACT, ACT + 16 * pg8::ACT_MiB, ACT + 32 * pg8::ACT_MiB, SCN, (float*)(ws + WS_MLSTATE), (float*)(ws + WS_MLN), HN, u >> 4, u & 15);
    PHASE_END
#if defined(PROBE_ML) && PROBE_ML != 2
    PHASE_BEGIN
        for (int u = vcu; u < 256; u += G) ml::seg_pass<true, PROBE_MLV>(lds, ACT, ACT + 16 * pg8::ACT_MiB, ACT + 32 * pg8::ACT_MiB, SCN, (float*)(ws + WS_MLSTATE), (float*)(ws + WS_MLN), HN, u >> 4, u & 15);
    PHASE_END
#endif
    PHASE_BEGIN ml::finalize(HN, ACT + 64 * pg8::ACT_MiB, ACT + 96 * pg8::ACT_MiB, args.ml_norm_g, gw, NGW, lane); PHASE_END
    PHASE_BEGIN GEMM_OUT(WS_W_ML_OUT, args.out); PHASE_END
    PHASE_BEGIN norm_rows<false>(args.out, args.norm_g + 3 * 2048, HN, gw, NGW, lane, nullptr, nullptr, nullptr); PHASE_END
#ifdef PROBE_NORM
    PHASE_BEGIN norm_rows<false>(args.out, args.norm_g + 3 * 2048, HN, gw, NGW, lane, nullptr, nullptr, nullptr); PHASE_END
#endif
    PHASE_BEGIN GEMM_IN(0, WS_W_DA1_IN, 8192, WS_ROPEA_C, WS_ROPEA_S); PHASE_END
#ifdef PROBE_GEMM
    PHASE_BEGIN GEMM_IN2(0, WS_W_DA1_IN, 8192, WS_ROPEA_C, WS_ROPEA_S, PROBE_GEMM - 1); PHASE_END
#endif
    PHASE_BEGIN DA_ATTN(1, 0.55605820924f, 0); PHASE_END
    PHASE_BEGIN GEMM_OUT(WS_W_DA1_OUT, args.out); PHASE_END
    PHASE_BEGIN final_norm_rows(args.out, args.final_g, gw, NGW, lane); PHASE_END
}

extern "C" void kernel_launch(void* const* d_in, const int* in_sizes, int n_in, void* d_out, int out_size, void* d_ws, size_t ws_size, hipStream_t stream) {
    static int grid = 0;
    if (grid == 0) {
        if (n_in != 15 || out_size != TOK * DM || ws_size < WS_END) { fprintf(stderr, "kernel_launch: unexpected problem (n_in %d out %d ws %zu)\n", n_in, out_size, ws_size); grid = -1; return; }
        int dev = 0, cus = 0, per_cu = 0;
        hipGetDevice(&dev); hipDeviceGetAttribute(&cus, hipDeviceAttributeMultiprocessorCount, dev);
        if (hipFuncSetAttribute((const void*)hybrid_fwd, hipFuncAttributeMaxDynamicSharedMemorySize, LDS_BYTES) != hipSuccess) { fprintf(stderr, "kernel_launch: hipFuncSetAttribute failed\n"); grid = -1; return; }
        hipOccupancyMaxActiveBlocksPerMultiprocessor(&per_cu, (const void*)hybrid_fwd, 512, LDS_BYTES);
        (void)hipGetLastError();
        if (per_cu < 1) per_cu = 1;
        grid = cus * 1;
        fprintf(stderr, "kernel_launch: %d CUs, occupancy query %d block(s)/CU, grid %d\n", cus, per_cu, grid);
    }
    if (grid < 0) return;
    if (hipMemsetAsync((char*)d_ws + 4096, 0, 16384, stream) != hipSuccess) { fprintf(stderr, "kernel_launch: memset of the barrier words failed\n"); return; }
    Args a{};
    a.x = (const float*)d_in[0]; a.pos = (const int*)d_in[1]; a.norm_g = (const float*)d_in[2]; a.final_g = (const float*)d_in[3];
    a.da_w_in = (const float*)d_in[4]; a.da_w_out = (const float*)d_in[5]; a.da_lambda = (const float*)d_in[6]; a.da_subln = (const float*)d_in[7];
    a.sw_w_in = (const float*)d_in[8]; a.sw_w_out = (const float*)d_in[9]; a.sw_sinks = (const float*)d_in[10];
    a.ml_w_in = (const float*)d_in[11]; a.ml_b_gates = (const float*)d_in[12]; a.ml_w_out = (const float*)d_in[13]; a.ml_norm_g = (const float*)d_in[14];
    a.out = (float*)d_out; a.ws = (unsigned char*)d_ws;
#if MK_LAUNCHES == 1
    a.ph_lo = 0; a.ph_hi = N_PHASES;
    { void* kargs[] = {&a}; hipError_t e = hipLaunchCooperativeKernel((const void*)hybrid_fwd, dim3(grid), dim3(512), kargs, LDS_BYTES, stream);
      if (e != hipSuccess) fprintf(stderr, "cooperative launch failed: %s (grid %d)\n", hipGetErrorString(e), grid); }
#else
    for (int p = 0; p < N_PHASES; ++p) { a.ph_lo = p; a.ph_hi = p + 1; void* kargs[] = {&a};
        hipError_t e = hipLaunchCooperativeKernel((const void*)hybrid_fwd, dim3(grid), dim3(512), kargs, LDS_BYTES, stream);
        if (e != hipSuccess) { fprintf(stderr, "cooperative launch %d failed: %s (grid %d)\n", p, hipGetErrorString(e), grid); break; } }
#endif
}
```

```cpp
#include <hip/hip_runtime.h>
#include <hip/hip_cooperative_groups.h>
#include <cstdio>
#include <cstdint>
namespace cg = cooperative_groups;
#define LAS __attribute__((address_space(3)))
typedef unsigned short bf16_t;
typedef short bf16x8 __attribute__((ext_vector_type(8)));
typedef short s16x4 __attribute__((ext_vector_type(4)));
typedef float f32x4 __attribute__((ext_vector_type(4)));
typedef float f32x16 __attribute__((ext_vector_type(16)));
typedef unsigned u32x4 __attribute__((ext_vector_type(4)));
typedef unsigned u32x2 __attribute__((ext_vector_type(2)));
__device__ __forceinline__ unsigned cvtpk(float lo, float hi) { typedef float f2_t __attribute__((ext_vector_type(2))); typedef __bf16 b2_t __attribute__((ext_vector_type(2))); f2_t v = {lo, hi}; b2_t b = __builtin_convertvector(v, b2_t); return __builtin_bit_cast(unsigned, b); }
__device__ __forceinline__ float bf2f(unsigned short v) { return __uint_as_float(((unsigned)v) << 16); }
__device__ __forceinline__ float bflo(unsigned v) { return __uint_as_float(v << 16); }
__device__ __forceinline__ float bfhi(unsigned v) { return __uint_as_float(v & 0xffff0000u); }
constexpr float LOG2E = 1.4426950408889634f;
__device__ __forceinline__ float fsigmoid(float x) { return 1.0f / (1.0f + __expf(-x)); }
namespace pg8 {
#define PG8_LAS __attribute__((address_space(3)))
typedef unsigned short bf16_t;
typedef short bf16x8 __attribute__((ext_vector_type(8)));
typedef float f32x4 __attribute__((ext_vector_type(4)));
typedef unsigned u32x4 __attribute__((ext_vector_type(4)));
constexpr int BM = 256, BK = 64, HALF = 128, HTB = HALF * BK * 2  , STAGE_BYTES = 8 * HTB, NXCD = 8, WGM = 8;

__host__ __device__ __forceinline__ int lds_byte(int r, int c) { const int st = (r >> 4) * 2 + (c >> 5), rr = r & 15, cc = c & 31, ob = rr * 64 + cc * 2; return st * 1024 + (ob ^ (((ob >> 9) & 1) << 5)); }
__host__ __device__ __forceinline__ void stage_rc(int b, int& R, int& C) { const int st = b / 1024, sb = b % 1024, swz = sb ^ (((sb >> 9) & 1) << 5); R = (st >> 1) * 16 + swz / 64; C = (st & 1) * 32 + (swz % 64) / 2; }
__host__ __device__ __forceinline__ int perm32(int rho) { const int n = rho >> 4, i = rho & 15; return 8 * (i >> 2) + 4 * n + (i & 3); }

struct Unit { int pm, pn; };
struct Gemm { const bf16_t* A; const bf16_t* Bt; int M, N, K; };

struct StaticOrder {
    int nM, nN, nwg, G, c;
    __host__ __device__ void init(int M, int N, int G_, int c_) { nM = M / BM; nN = N / BM; nwg = nM * nN; G = G_; c = c_; }
    __host__ __device__ bool next(int i, Unit& u) const {
        const long L = (long)i * G + c; if (L >= nwg) return false;
        int wgid = (int)L; { const int q = nwg / NXCD, r = nwg % NXCD, xcd = wgid % NXCD, off = wgid / NXCD; wgid = (xcd < r ? xcd * (q + 1) : r * (q + 1) + (xcd - r) * q) + off; }
        const int nig = WGM * nN, gid = wgid / nig, fm = gid * WGM, gsz = (nM - fm) < WGM ? (nM - fm) : WGM;
        u.pm = fm + ((wgid % nig) % gsz); u.pn = (wgid % nig) / gsz; return true;
    }
    __device__ __forceinline__ void a_ready(const Unit&) const {}
    __device__ __forceinline__ void done(const Unit&) const {}
};

__device__ __forceinline__ void epi_plain(const f32x4 (&acc)[2][2][4][2], bf16_t* base, size_t stride, size_t ct0, size_t ct1, int act, float scale, int wr, int fr) {
    bf16_t* rowp = base + (size_t)(wr * 64 + fr) * stride;
#pragma unroll
    for (int ai = 0; ai < 2; ++ai)
#pragma unroll
        for (int m = 0; m < 4; ++m) {
#pragma unroll
            for (int bj = 0; bj < 2; ++bj) { f32x4 v0 = acc[ai][bj][m][0], v1 = acc[ai][bj][m][1];
                if (act == 0) { v0 = v0 * scale; v1 = v1 * scale; }
                else {
#pragma unroll
                    for (int j = 0; j < 4; ++j) { const float s0 = __builtin_amdgcn_rcpf(1.0f + __expf(-v0[j])), s1 = __builtin_amdgcn_rcpf(1.0f + __expf(-v1[j])); v0[j] = (act == 1) ? v0[j] * s0 : s0; v1[j] = (act == 1) ? v1[j] * s1 : s1; } }
                u32x4 w; w.x = ::cvtpk(v0[0], v0[1]); w.y = ::cvtpk(v0[2], v0[3]); w.z = ::cvtpk(v1[0], v1[1]); w.w = ::cvtpk(v1[2], v1[3]);
                *(u32x4*)(rowp + (bj ? ct1 : ct0)) = w; }
            rowp += (m == 3 ? (size_t)(HALF - 48) : (size_t)16) * stride;
            asm volatile("" : "+v"(rowp) :: "memory"); }
}
__device__ __forceinline__ void epi_rope(const f32x4 (&acc)[2][2][4][2], bf16_t* rowp, size_t adv_m, size_t adv_m1, size_t adv_ai, size_t half_off, const float* cp, const float* sp, int tstride, float scale) {
#pragma unroll
    for (int ai = 0; ai < 2; ++ai)
#pragma unroll
        for (int m = 0; m < 4; ++m) {
            { const f32x4 c0 = *(const f32x4*)(cp), c1 = *(const f32x4*)(cp + 4), s0 = *(const f32x4*)(sp), s1 = *(const f32x4*)(sp + 4);
              const f32x4 a0 = acc[ai][0][m][0], a1 = acc[ai][0][m][1], b0 = acc[ai][1][m][0], b1 = acc[ai][1][m][1];
              const f32x4 o10 = (a0 * c0 - b0 * s0) * scale, o11 = (a1 * c1 - b1 * s1) * scale, o20 = (b0 * c0 + a0 * s0) * scale, o21 = (b1 * c1 + a1 * s1) * scale;
              u32x4 w; w.x = ::cvtpk(o10[0], o10[1]); w.y = ::cvtpk(o10[2], o10[3]); w.z = ::cvtpk(o11[0], o11[1]); w.w = ::cvtpk(o11[2], o11[3]);
              *(u32x4*)rowp = w;
              w.x = ::cvtpk(o20[0], o20[1]); w.y = ::cvtpk(o20[2], o20[3]); w.z = ::cvtpk(o21[0], o21[1]); w.w = ::cvtpk(o21[2], o21[3]);
              *(u32x4*)(rowp + half_off) = w; }
            const size_t adv = (m == 3 ? (size_t)(HALF - 48) : (size_t)16);
            rowp += (m == 3 ? adv_ai : (m == 1 ? adv_m1 : adv_m)); cp += adv * tstride; sp += adv * tstride;
            asm volatile("" : "+v"(rowp), "+v"(cp), "+v"(sp) :: "memory"); }
}
constexpr size_t ACT_MiB = 1u << 20;
struct EpiProj {
    static constexpr bool PERM = true, AFTER_DRAIN = false;
    int kind; bf16_t* act; const float* cosT; const float* sinT; int skip;
    __device__ __forceinline__ void operator()(const f32x4 (&acc)[2][2][4][2], const Unit& u, int wr, int wc, int fr, int fq) const {
        if (skip) {
            f32x4 t = acc[0][0][0][0];
#pragma unroll
            for (int a = 0; a < 2; ++a)
#pragma unroll
                for (int b2 = 0; b2 < 2; ++b2)
#pragma unroll
                    for (int m = 0; m < 4; ++m)
#pragma unroll
                        for (int n = 0; n < 2; ++n) t += acc[a][b2][m][n];
            if (t[0] + t[1] + t[2] + t[3] == 12345.678f) act[0] = 1;
            return; }
        const int pn = u.pn, row0 = u.pm * BM, b = row0 >> 13, s0 = row0 & 8191;
        const size_t cp = (size_t)(wc * 32 + 8 * fq);
        bf16_t* G = act + 96 * ACT_MiB;
        const int rl0 = wr * 64 + fr;
        bool rope = false; bf16_t* base = G; size_t stride = 2048, ct0 = cp, ct1 = 128 + cp; int ac = 1; float scale = 1.0f;
        if (kind == 0) {
            if (pn < 16) {
                rope = true;
                const int h = pn & 7, isk = pn >> 3, map = wc >> 1, c1 = (wc & 1) * 32 + 8 * fq;
                const float* cpp = cosT + (size_t)(row0 + rl0) * 64 + c1; const float* spp = sinT + (size_t)(row0 + rl0) * 64 + c1;
                if (!isk) { bf16_t* q = act + ((size_t)((b * 8 + h) * 2 + map) * 8192 + s0 + rl0) * 128 + c1;
                    epi_rope(acc, q, 16 * 128, 16 * 128, (size_t)(HALF - 48) * 128, 64, cpp, spp, 64, 0.08838834764831845f * LOG2E); }
                else {
                    bf16_t* k = act + 32 * ACT_MiB + ((size_t)((b * 8 + h) * 2 + map) * 8192 + s0) * 128 + (size_t)(2 * wr) * 4096 + (size_t)(c1 >> 3) * 256 + (size_t)fr * 8;
                    epi_rope(acc, k, 128, 4096 - 128, (size_t)3 * 4096 - 128, 8 * 256, cpp, spp, 64, 1.0f); }
            } else if (pn < 24) { base = act + 64 * ACT_MiB + ((size_t)(b * 8 + (pn - 16)) * 8192 + s0) * 256; stride = 256; ac = 0; }
            else base = G + (size_t)row0 * 2048 + (pn - 24) * 256;
        } else if (kind == 1) {
            if (pn < 9) {
                rope = true;
                const int c1 = 8 * fq;
                bf16_t* bq = (pn < 8) ? act + ((size_t)(b * 32 + pn * 4 + wc) * 8192 + s0 + rl0) * 64 + c1 : act + 32 * ACT_MiB + ((size_t)(b * 4 + wc) * 8192 + s0 + rl0) * 64 + c1;
                epi_rope(acc, bq, 16 * 64, 16 * 64, (size_t)(HALF - 48) * 64, 32, cosT + (size_t)(row0 + rl0) * 32 + c1, sinT + (size_t)(row0 + rl0) * 32 + c1, 32, (pn < 8) ? 0.125f * LOG2E : 1.0f);
            } else if (pn == 9) {
                base = act + 36 * ACT_MiB + ((size_t)(b * 4) * 8192 + s0) * 64; stride = 64; ac = 0;
                ct0 = (size_t)(wc >> 1) * 8192 * 64 + (wc & 1) * 32 + 8 * fq; ct1 = ct0 + (size_t)2 * 8192 * 64;
            } else base = G + (size_t)row0 * 2048 + (pn - 10) * 256;
        } else {
            if (pn < 8) {
                base = act + ((pn < 4) ? 0 : 16 * ACT_MiB) + ((size_t)(b * 8) * 8192 + s0) * 128; stride = 128; ac = 0;
                ct0 = (size_t)(2 * (pn & 3)) * 8192 * 128 + cp; ct1 = ct0 + (size_t)8192 * 128; scale = (pn < 4) ? 0.08838834764831845f : 1.0f;
            } else if (pn < 16) { base = act + 32 * ACT_MiB + ((size_t)(b * 8 + (pn - 8)) * 8192 + s0) * 256; stride = 256; ac = 0; }
            else if (pn < 24) { base = act + 64 * ACT_MiB + (size_t)row0 * 2048 + (pn - 16) * 256; ac = 2; }
            else base = G + (size_t)row0 * 2048 + (pn - 24) * 256;
        }
        if (!rope) epi_plain(acc, base, stride, ct0, ct1, ac, scale, wr, fr);
    }
};
struct EpiRes {
    static constexpr bool PERM = false, AFTER_DRAIN = false;
    const float* xin; float* xout;
    __device__ __forceinline__ void operator()(const f32x4 (&acc)[2][2][4][2], const Unit& u, int wr, int wc, int fr, int fq) const {
        const int col0 = u.pn * BM + wc * 32 + 4 * fq;
#pragma unroll
        for (int ai = 0; ai < 2; ++ai)
#pragma unroll
            for (int m = 0; m < 4; ++m) { const size_t off = (size_t)(u.pm * BM + ai * HALF + wr * 64 + m * 16 + fr) * 2048 + col0;
#pragma unroll
                for (int bj = 0; bj < 2; ++bj)
#pragma unroll
                    for (int n = 0; n < 2; ++n) { const f32x4 bs = *(const f32x4*)(xin + off + bj * HALF + n * 16); *(f32x4*)(xout + off + bj * HALF + n * 16) = bs + acc[ai][bj][m][n]; }
                if (m & 1) asm volatile("" ::: "memory"); }
    }
};
template <class Epi, class Sched, bool ALIGN_EPI = false, bool SP2 = false>
__device__ __forceinline__ void gemm_phase(PG8_LAS unsigned char* lds, const Gemm g, const Sched& S, const Epi& E) {
    const int tid = threadIdx.x, wid = __builtin_amdgcn_readfirstlane(tid >> 6), lane = tid & 63, wr = wid >> 2, wc = wid & 3, fr = lane & 15, fq = lane >> 4;
    const int K = g.K, nt = K / BK;
    unsigned voffA[2], voffB[2];
#pragma unroll
    for (int i = 0; i < 2; ++i) { int R, C; stage_rc(tid * 16 + i * 8192, R, C); const int Rb = Epi::PERM ? ((R & ~31) + perm32(R & 31)) : R;
        voffA[i] = (unsigned)(R * K + C) * 2u; voffB[i] = (unsigned)(Rb * K + C) * 2u; }
    const size_t kstep = (size_t)(BK * 2);
    const size_t hstep = (size_t)HALF * K * 2;
    const size_t tstep = 2 * hstep;
    const unsigned ldsw = (unsigned)wid * 1024u;
    const int aoff = lds_byte(wr * 64 + fr, fq * 8), boff = lds_byte(wc * 32 + fr, fq * 8);
#define PG8_SA(b, h) (((b) * 2 + (h)) * HTB)
#define PG8_SB(b, h) ((4 + (b) * 2 + (h)) * HTB)
#define PG8_STAGE(bufoff, gbase, voff) do { _Pragma("unroll") for (int _i = 0; _i < 2; ++_i) \
        __builtin_amdgcn_global_load_lds((const unsigned*)((const char*)(gbase) + (voff)[_i]), (PG8_LAS unsigned*)(lds + (bufoff) + ldsw + _i * 8192), 16, 0, 0); } while (0)
#define PG8_LDA(dst, b, h) do { _Pragma("unroll") for (int m = 0; m < 4; ++m) _Pragma("unroll") for (int k = 0; k < 2; ++k) dst[m][k] = *(const PG8_LAS bf16x8*)(lds + PG8_SA(b, h) + aoff + m * 2048 + k * 1024); } while (0)
#define PG8_LDB(dst, b, h) do { _Pragma("unroll") for (int n = 0; n < 2; ++n) _Pragma("unroll") for (int k = 0; k < 2; ++k) dst[n][k] = *(const PG8_LAS bf16x8*)(lds + PG8_SB(b, h) + boff + n * 2048 + k * 1024); } while (0)
#define PG8_MMA(ai, bj, At, Bt) do { __builtin_amdgcn_s_setprio(1); _Pragma("unroll") for (int m = 0; m < 4; ++m) _Pragma("unroll") for (int n = 0; n < 2; ++n) _Pragma("unroll") for (int k = 0; k < 2; ++k) \
        acc[ai][bj][m][n] = __builtin_amdgcn_mfma_f32_16x16x32_bf16(Bt[n][k], At[m][k], acc[ai][bj][m][n], 0, 0, 0); __builtin_amdgcn_s_setprio(0); } while (0)
#define PG8_WAIT_V(n) asm volatile("s_waitcnt vmcnt(" #n ")" ::: "memory")
#define PG8_WAIT_L(n) asm volatile("s_waitcnt lgkmcnt(" #n ")" ::: "memory")
#define PG8_BAR __builtin_amdgcn_s_barrier()
#define PG8_SCHED __builtin_amdgcn_sched_barrier(0)
    Unit cur, nxt; int ui = 0;
    if (!S.next(0, cur)) return;
    f32x4 acc[2][2][4][2];
#pragma unroll
    for (int a = 0; a < 2; ++a)
#pragma unroll
        for (int b = 0; b < 2; ++b)
#pragma unroll
            for (int m = 0; m < 4; ++m)
#pragma unroll
                for (int n = 0; n < 2; ++n) acc[a][b][m][n] = (f32x4){0.f, 0.f, 0.f, 0.f};
    bf16x8 At[4][2], B0[2][2], B1[2][2];
    const char* cA = (const char*)g.A + (size_t)cur.pm * tstep; const char* cB = (const char*)g.Bt + (size_t)cur.pn * tstep;
    S.a_ready(cur);
    if constexpr (SP2) {
        PG8_STAGE(PG8_SB(0, 0), cB, voffB); PG8_STAGE(PG8_SB(0, 1), cB + hstep, voffB); PG8_STAGE(PG8_SA(0, 0), cA, voffA); PG8_STAGE(PG8_SA(0, 1), cA + hstep, voffA);
        if (wr == 1) PG8_BAR;
        PG8_WAIT_V(2); PG8_BAR;
        PG8_STAGE(PG8_SB(1, 0), cB + kstep, voffB); PG8_STAGE(PG8_SA(1, 0), cA + kstep, voffA); PG8_STAGE(PG8_SB(1, 1), cB + hstep + kstep, voffB);
        PG8_WAIT_V(6); PG8_BAR;
    } else {
        PG8_STAGE(PG8_SB(0, 0), cB, voffB); PG8_STAGE(PG8_SA(0, 0), cA, voffA); PG8_STAGE(PG8_SB(0, 1), cB + hstep, voffB); PG8_STAGE(PG8_SA(0, 1), cA + hstep, voffA);
        if (wr == 1) PG8_BAR;
        PG8_WAIT_V(4); PG8_BAR;
        PG8_STAGE(PG8_SB(1, 0), cB + kstep, voffB); PG8_STAGE(PG8_SA(1, 0), cA + kstep, voffA); PG8_STAGE(PG8_SB(1, 1), cB + hstep + kstep, voffB);
        PG8_WAIT_V(6); PG8_BAR;
    }
    for (;;) {
        const bool has_next = S.next(ui + 1, nxt);
        const char* nA = has_next ? (const char*)g.A + (size_t)nxt.pm * tstep : cA; const char* nB = has_next ? (const char*)g.Bt + (size_t)nxt.pn * tstep : cB;
        for (int t = 0; t < nt; t += 2) {
            const bool last = (t == nt - 2);
            const char* a1 = cA + (size_t)(t + 1) * kstep;
            const char* a2 = last ? nA : cA + (size_t)(t + 2) * kstep; const char* b2 = last ? nB : cB + (size_t)(t + 2) * kstep;
            const char* a3 = a2 + kstep; const char* b3 = b2 + kstep;
            if (last && has_next) S.a_ready(nxt);
            if constexpr (SP2) {
            PG8_LDB(B0, 0, 0); PG8_LDB(B1, 0, 1); PG8_SCHED; PG8_LDA(At, 0, 0); PG8_STAGE(PG8_SA(1, 1), a1 + hstep, voffA);
            PG8_WAIT_V(8); PG8_WAIT_L(0); PG8_BAR; PG8_MMA(0, 0, At, B0); PG8_MMA(0, 1, At, B1); PG8_BAR; PG8_SCHED;
            PG8_LDA(At, 0, 1); PG8_STAGE(PG8_SB(0, 0), b2, voffB); PG8_STAGE(PG8_SB(0, 1), b2 + hstep, voffB); PG8_STAGE(PG8_SA(0, 0), a2, voffA);
            PG8_WAIT_V(8); PG8_WAIT_L(0); PG8_BAR; PG8_MMA(1, 0, At, B0); PG8_MMA(1, 1, At, B1); PG8_BAR; PG8_SCHED;
            PG8_LDB(B0, 1, 0); PG8_LDB(B1, 1, 1); PG8_SCHED; PG8_LDA(At, 1, 0); PG8_STAGE(PG8_SA(0, 1), a2 + hstep, voffA);
            PG8_WAIT_V(8); PG8_WAIT_L(0); PG8_BAR; PG8_MMA(0, 0, At, B0); PG8_MMA(0, 1, At, B1); PG8_BAR; PG8_SCHED;
            PG8_LDA(At, 1, 1); PG8_STAGE(PG8_SB(1, 0), b3, voffB); PG8_STAGE(PG8_SB(1, 1), b3 + hstep, voffB); PG8_STAGE(PG8_SA(1, 0), a3, voffA);
            PG8_WAIT_V(8); PG8_WAIT_L(0); PG8_BAR; PG8_MMA(1, 0, At, B0); PG8_MMA(1, 1, At, B1); PG8_BAR; PG8_SCHED;
            } else {
            PG8_LDB(B0, 0, 0); PG8_SCHED; PG8_LDA(At, 0, 0); PG8_STAGE(PG8_SA(1, 1), a1 + hstep, voffA);
            PG8_WAIT_L(8); PG8_BAR; PG8_WAIT_L(0); PG8_MMA(0, 0, At, B0); PG8_BAR; PG8_SCHED;
            PG8_LDB(B1, 0, 1); PG8_STAGE(PG8_SB(0, 0), b2, voffB);
            PG8_BAR; PG8_WAIT_L(0); PG8_MMA(0, 1, At, B1); PG8_BAR;
            PG8_LDA(At, 0, 1); PG8_STAGE(PG8_SA(0, 0), a2, voffA);
            PG8_BAR; PG8_WAIT_L(0); PG8_MMA(1, 0, At, B0); PG8_BAR; PG8_SCHED;
            PG8_STAGE(PG8_SB(0, 1), b2 + hstep, voffB);
            PG8_WAIT_V(6); PG8_BAR; PG8_MMA(1, 1, At, B1); PG8_BAR;
            PG8_LDB(B0, 1, 0); PG8_SCHED; PG8_LDA(At, 1, 0); PG8_STAGE(PG8_SA(0, 1), a2 + hstep, voffA);
            PG8_WAIT_L(8); PG8_BAR; PG8_WAIT_L(0); PG8_MMA(0, 0, At, B0); PG8_BAR; PG8_SCHED;
            PG8_LDB(B1, 1, 1); PG8_STAGE(PG8_SB(1, 0), b3, voffB);
            PG8_BAR; PG8_WAIT_L(0); PG8_MMA(0, 1, At, B1); PG8_BAR;
            PG8_LDA(At, 1, 1); PG8_STAGE(PG8_SA(1, 0), a3, voffA);
            PG8_BAR; PG8_WAIT_L(0); PG8_MMA(1, 0, At, B0); PG8_BAR; PG8_SCHED;
            PG8_STAGE(PG8_SB(1, 1), b3 + hstep, voffB);
            PG8_WAIT_V(6); PG8_BAR; PG8_MMA(1, 1, At, B1); PG8_BAR;
            }
        }
        if constexpr (ALIGN_EPI) { if (wr == 0) PG8_BAR; }
        if constexpr (!Epi::AFTER_DRAIN) { E(acc, cur, wr, wc, fr, fq); S.done(cur); }
        if (!has_next) break;
#pragma unroll
        for (int a = 0; a < 2; ++a)
#pragma unroll
            for (int b = 0; b < 2; ++b)
#pragma unroll
                for (int m = 0; m < 4; ++m)
#pragma unroll
                    for (int n = 0; n < 2; ++n) acc[a][b][m][n] = (f32x4){0.f, 0.f, 0.f, 0.f};
        cur = nxt; cA = nA; cB = nB; ++ui;
        if constexpr (ALIGN_EPI) { if (wr == 1) PG8_BAR; }
    }
    PG8_WAIT_V(0);
    if constexpr (!ALIGN_EPI) { if (wr == 0) PG8_BAR; }
    PG8_BAR;
    if constexpr (Epi::AFTER_DRAIN) { E.fused(acc, cur, wr, wc, fr, fq, lds, wid, lane); S.done(cur); }
#undef PG8_SA
#undef PG8_SB
#undef PG8_STAGE
#undef PG8_LDA
#undef PG8_LDB
#undef PG8_MMA
#undef PG8_WAIT_V
#undef PG8_WAIT_L
#undef PG8_BAR
#undef PG8_SCHED
}
}

constexpr int TOK = 16384, DM = 2048, SEQL = 8192;
constexpr size_t MiB = 1u << 20;
constexpr size_t WS_ROPEA_C = 1 * MiB, WS_ROPEA_S = 5 * MiB, WS_ROPEB_C = 9 * MiB, WS_ROPEB_S = 11 * MiB, WS_GIF = 13 * MiB, WS_SCAN = 14 * MiB;
constexpr size_t WS_W_DA0_IN = 16 * MiB, WS_W_DA0_OUT = 48 * MiB, WS_W_SW_IN = 56 * MiB, WS_W_SW_OUT = 74 * MiB, WS_W_ML_IN = 82 * MiB, WS_W_ML_OUT = 114 * MiB, WS_W_DA1_IN = 122 * MiB, WS_W_DA1_OUT = 154 * MiB;
constexpr size_t WS_HN = 162 * MiB, WS_ACT = 226 * MiB, WS_END = 482 * MiB;
constexpr size_t WS_MLSTATE = 16 * MiB;
constexpr size_t WS_MLN = 48 * MiB;
constexpr int SC_BL = 0, SC_II = 131072, SC_MT = 262144, SC_MC = 393216, SC_SD = 393216 + 4096;
constexpr int LDS_BYTES = 147456, RING_BYTES = 131072, MISC_OFF = 131072;
constexpr int NWAVES = 8;

__device__ __forceinline__ float wave_sum(float v) {
#pragma unroll
    for (int o = 1; o < 64; o <<= 1) v += __shfl_xor(v, o);
    return v;
}
__device__ __forceinline__ int crow(int r, int hi) { return (r & 3) + 8 * (r >> 2) + 4 * hi; }
__device__ __forceinline__ bf16x8 pack8(float a0, float a1, float a2, float a3, float a4, float a5, float a6, float a7) {
    u32x4 w; w.x = cvtpk(a0, a1); w.y = cvtpk(a2, a3); w.z = cvtpk(a4, a5); w.w = cvtpk(a6, a7); return __builtin_bit_cast(bf16x8, w);
}
__device__ __forceinline__ bf16x8 cat4(s16x4 lo, s16x4 hi) { return (bf16x8){lo[0], lo[1], lo[2], lo[3], hi[0], hi[1], hi[2], hi[3]}; }
typedef short v4i16_t __attribute__((ext_vector_type(4)));
__device__ __forceinline__ s16x4 trrd(const LAS unsigned char* p) { return __builtin_bit_cast(s16x4, __builtin_amdgcn_ds_read_tr16_b64_v4i16((LAS v4i16_t*)p)); }
#define MFMA32(a, b, c) __builtin_amdgcn_mfma_f32_32x32x16_bf16((a), (b), (c), 0, 0, 0)
__device__ __forceinline__ int off256(int row, int ch) { return row * 256 + ((ch ^ (row & 15)) << 4); }
__device__ __forceinline__ int off512(int row, int ch) { return row * 512 + ((ch ^ ((row & 3) << 2)) << 4); }
__device__ __forceinline__ int off128k(int row, int ch) { return row * 128 + ((ch ^ (row & 7)) << 4); }
__device__ __forceinline__ int off128v(int row, int ch) { return row * 128 + ((ch ^ (((row >> 1) & 1) << 2)) << 4); }

__device__ __forceinline__ void transpose_item(const float* W, int K, int Nsrc, bf16_t* WT, int n_phys0, int n_src0, int k0, LAS float* scr, int lane) {
#pragma unroll 8
    for (int i = 0; i < 32; ++i) { const int kk = 2 * i + (lane >> 5); scr[kk * 33 + (lane & 31)] = W[(size_t)(k0 + kk) * Nsrc + n_src0 + (lane & 31)]; }
    asm volatile("s_waitcnt lgkmcnt(0)" ::: "memory");
    const int c = lane & 7;
#pragma unroll
    for (int j = 0; j < 4; ++j) { const int n = (lane >> 3) + 8 * j; const LAS float* s = scr + (8 * c) * 33 + n;
        u32x4 o; o.x = cvtpk(s[0 * 33], s[1 * 33]); o.y = cvtpk(s[2 * 33], s[3 * 33]); o.z = cvtpk(s[4 * 33], s[5 * 33]); o.w = cvtpk(s[6 * 33], s[7 * 33]);
        *(u32x4*)(WT + (size_t)(n_phys0 + n) * K + k0 + 8 * c) = o; }
    asm volatile("s_waitcnt lgkmcnt(0)" ::: "memory");
}
__device__ __forceinline__ int src_col(int mode, int nb) {
    const int tile = nb >> 3, g = nb & 7, bj = g >> 2, wc = g & 3;
    if (mode == 1 && tile < 16) return tile * 256 + (wc >> 1) * 128 + ((wc & 1) + 2 * bj) * 32;
    if (mode == 2 && tile < 9) return tile * 256 + wc * 64 + bj * 32;
    int p = nb * 32;
    if (mode == 3 && p >= 6144) p += 16;
    return p;
}
struct CvMat { const float* W; bf16_t* WT; int Nsrc, Nphys, mode; };
__device__ __forceinline__ void cv_load(const CvMat& m, int item, int lane, f32x4 (&v)[16]) {
    const int nblk = m.Nphys / 64, kb = item / nblk, nb2 = item % nblk, k0 = kb * 64;
    const int col4 = (lane & 15) * 4, src = ((col4 >> 5) ? src_col(m.mode, 2 * nb2 + 1) : src_col(m.mode, 2 * nb2)) + (col4 & 31);
    const float* p = m.W + (size_t)(k0 + (lane >> 4)) * m.Nsrc + src;
#pragma unroll
    for (int i = 0; i < 16; ++i) v[i] = *(const f32x4*)(p + (size_t)(4 * i) * m.Nsrc);
}
__device__ __forceinline__ void cv_store(const CvMat& m, int item, int lane, const f32x4 (&v)[16], LAS float* scr) {
    const int nblk = m.Nphys / 64, kb = item / nblk, nb2 = item % nblk, k0 = kb * 64, n_phys0 = nb2 * 64, col4 = (lane & 15) * 4;
#pragma unroll
    for (int i = 0; i < 16; ++i) { LAS float* d = scr + (4 * i + (lane >> 4)) * 65 + col4; d[0] = v[i].x; d[1] = v[i].y; d[2] = v[i].z; d[3] = v[i].w; }
    asm volatile("s_waitcnt lgkmcnt(0)" ::: "memory");
    const int c = lane & 7;
#pragma unroll
    for (int j = 0; j < 8; ++j) { const int n = (lane >> 3) + 8 * j; const LAS float* sp = scr + (8 * c) * 65 + n;
        u32x4 o; o.x = cvtpk(sp[0 * 65], sp[1 * 65]); o.y = cvtpk(sp[2 * 65], sp[3 * 65]); o.z = cvtpk(sp[4 * 65], sp[5 * 65]); o.w = cvtpk(sp[6 * 65], sp[7 * 65]);
        *(u32x4*)(m.WT + (size_t)(n_phys0 + n) * 2048 + k0 + 8 * c) = o; }
    asm volatile("s_waitcnt lgkmcnt(0)" ::: "memory");
}
__device__ __forceinline__ void cv_decode(const CvMat& a, const CvMat& b, const CvMat& c, const CvMat& d, int na, int nb, int nc, int it, CvMat& m, int& r) {
    r = it; m = a;
    if (r >= na) { r -= na; m = b; if (r >= nb) { r -= nb; m = c; if (r >= nc) { r -= nc; m = d; } } }
}
__device__ __forceinline__ void convert_set(const CvMat& a, const CvMat& b, const CvMat& c, const CvMat& d, int na, int nb, int nc, int nd, int first, int step, LAS float* scr, int lane) {
    const int total = na + nb + nc + nd;
    if (first >= total) return;
    f32x4 v[16], vn[16]; CvMat m, mn; int r, rn;
    cv_decode(a, b, c, d, na, nb, nc, first, m, r); cv_load(m, r, lane, v);
    for (int it = first; it < total; it += step) {
        const bool more = it + step < total;
        if (more) { cv_decode(a, b, c, d, na, nb, nc, it + step, mn, rn); cv_load(mn, rn, lane, vn); }
        cv_store(m, r, lane, v, scr);
        if (more) { m = mn; r = rn;
#pragma unroll
            for (int i = 0; i < 16; ++i) v[i] = vn[i]; }
    }
}
template <bool GIF> __device__ __forceinline__ void norm_rows(const float* xin, const float* g, bf16_t* hn, int gw, int NGW, int lane, const LAS float* wg, const float* bg, float* gif) {
    for (int row = gw; row < TOK; row += NGW) {
        const f32x4* xr = (const f32x4*)(xin + (size_t)row * DM) + lane;
        f32x4 v[8]; float s = 0.f;
#pragma unroll
        for (int j = 0; j < 8; ++j) { v[j] = xr[64 * j]; s += (v[j].x * v[j].x + v[j].y * v[j].y) + (v[j].z * v[j].z + v[j].w * v[j].w); }
        const float r = 1.0f / sqrtf(wave_sum(s) * (1.0f / DM) + 1e-6f);
        u32x2* o8 = (u32x2*)(hn + (size_t)row * DM) + lane;
#pragma unroll
        for (int j = 0; j < 8; ++j) { const f32x4 gv = ((const f32x4*)g)[64 * j + lane]; v[j] = v[j] * r * gv; u32x2 w; w.x = cvtpk(v[j].x, v[j].y); w.y = cvtpk(v[j].z, v[j].w); o8[64 * j] = w; }
        if (GIF) {
            float mine = 0.f;
#pragma unroll 1
            for (int jj = 0; jj < 16; ++jj) { float p = 0.f;
#pragma unroll
                for (int j = 0; j < 8; ++j) { const f32x4 w = *(const LAS f32x4*)(wg + jj * 2048 + 256 * j + 4 * lane); p += (v[j].x * w.x + v[j].y * w.y) + (v[j].z * w.z + v[j].w * w.w); }
                p = wave_sum(p); if (lane == jj) mine = p; }
            if (lane < 16) gif[(size_t)row * 16 + lane] = mine + bg[lane];
        }
    }
}

constexpr int SC_BLC = 393216 + 8192, SC_CML = 393216 + 12288;
__device__ __forceinline__ void norm_gif_chunk(const float* xin, const float* g, bf16_t* hn, const LAS float* wg, LAS float* gl, const float* bg, float* sc, int cidx, int wave, int lane) {
    for (int i = 0; i < 8; ++i) {
        const int rl = wave * 8 + i, row = cidx * 64 + rl;
        const f32x4* xr = (const f32x4*)(xin + (size_t)row * DM) + lane;
        f32x4 v[8]; float s = 0.f;
#pragma unroll
        for (int j = 0; j < 8; ++j) { v[j] = xr[64 * j]; s += (v[j].x * v[j].x + v[j].y * v[j].y) + (v[j].z * v[j].z + v[j].w * v[j].w); }
        const float r = 1.0f / sqrtf(wave_sum(s) * (1.0f / DM) + 1e-6f);
        u32x2* o8 = (u32x2*)(hn + (size_t)row * DM) + lane;
#pragma unroll
        for (int j = 0; j < 8; ++j) { const f32x4 gv = ((const f32x4*)g)[64 * j + lane]; v[j] = v[j] * r * gv; u32x2 w; w.x = cvtpk(v[j].x, v[j].y); w.y = cvtpk(v[j].z, v[j].w); o8[64 * j] = w; }
        float mine = 0.f;
#pragma unroll 1
        for (int jj = 0; jj < 16; ++jj) { float p = 0.f;
#pragma unroll
            for (int j = 0; j < 8; ++j) { const f32x4 w = *(const LAS f32x4*)(wg + jj * 2048 + 256 * j + 4 * lane); p += (v[j].x * w.x + v[j].y * w.y) + (v[j].z * w.z + v[j].w * w.w); }
            p = wave_sum(p); if (lane == jj) mine = p; }
        if (lane < 16) gl[rl * 16 + lane] = mine + bg[lane];
    }
    __syncthreads();
    { const int h = wave, b = cidx >> 7, c = cidx & 127, bh = b * 8 + h, t = 64 * c + lane;
      const float ip = gl[lane * 16 + h], fp = gl[lane * 16 + 8 + h];
      const float lf = fminf(fp, 0.f) - log1pf(expf(-fabsf(fp)));
      float bs = lf;
#pragma unroll
      for (int o = 1; o < 64; o <<= 1) { const float vv = __shfl_up(bs, o); if (lane >= o) bs += vv; }
      float cm = ip - bs;
#pragma unroll
      for (int o = 1; o < 64; o <<= 1) { const float vv = __shfl_up(cm, o); if (lane >= o) cm = fmaxf(cm, vv); }
      sc[SC_BL + bh * 8192 + t] = bs; sc[SC_II + bh * 8192 + t] = ip; sc[SC_MT + bh * 8192 + t] = cm;
      if (lane == 63) { sc[SC_BLC + bh * 128 + c] = bs; sc[SC_CML + bh * 128 + c] = cm; } }
    __syncthreads();
}
__device__ __forceinline__ void final_norm_rows(float* x, const float* g, int gw, int NGW, int lane) {
    for (int row = gw; row < TOK; row += NGW) {
        f32x4* xr = (f32x4*)(x + (size_t)row * DM) + lane;
        f32x4 v[8]; float s = 0.f;
#pragma unroll
        for (int j = 0; j < 8; ++j) { v[j] = xr[64 * j]; s += (v[j].x * v[j].x + v[j].y * v[j].y) + (v[j].z * v[j].z + v[j].w * v[j].w); }
        const float r = 1.0f / sqrtf(wave_sum(s) * (1.0f / DM) + 1e-6f);
#pragma unroll
        for (int j = 0; j < 8; ++j) { const f32x4 gv = ((const f32x4*)g)[64 * j + lane]; xr[64 * j] = v[j] * r * gv; }
    }
}
__device__ __forceinline__ void rope_table(const int* pos, int nf, float* ct, float* st, int gtid, int ngt) {
    for (int i = gtid; i < TOK * nf; i += ngt) {
        const int tokn = i / nf, f = i - tokn * nf;
        const float invf = (float)exp2(-(double)f / (double)nf * 13.287712379549449);
        const float ang = (float)pos[tokn] * invf;
        double rv = (double)ang * 0.15915494309189535; rv -= floor(rv);
        const float rf = (float)rv;
        ct[i] = __builtin_amdgcn_cosf(rf); st[i] = __builtin_amdgcn_sinf(rf);
    }
}

namespace da {
constexpr int KSLOT = 16384, VBASE = 49152, VSLOT = 16384;
__device__ __forceinline__ void glds16(const void* gsrc, unsigned lds_dst) { unsigned keep;
    asm volatile("s_mov_b32 %0, m0\n\ts_mov_b32 m0, %2\n\ts_nop 0\n\tglobal_load_lds_dwordx4 %1, off\n\ts_mov_b32 m0, %0" : "=&s"(keep) : "v"(gsrc), "s"(lds_dst) : "memory"); }
__device__ __forceinline__ void issue_k(LAS unsigned char* lds, int slot, const bf16_t* K0, const bf16_t* K1, int t, int wid, int lane) {
    const unsigned d = (unsigned)(uintptr_t)(lds + slot * KSLOT + wid * 1024);
    glds16(K0 + (size_t)t * 4096 + (size_t)(wid * 64 + lane) * 8, (unsigned)__builtin_amdgcn_readfirstlane((int)d));
    glds16(K1 + (size_t)t * 4096 + (size_t)(wid * 64 + lane) * 8, (unsigned)__builtin_amdgcn_readfirstlane((int)(d + 8192u)));
}
__device__ __forceinline__ void issue_v(LAS unsigned char* lds, int slot, const bf16_t* V, int t, int wid, int lane) {
#pragma unroll
    for (int ii = 0; ii < 2; ++ii) { const int i = 2 * wid + ii, row = 2 * i + (lane >> 5), chp = lane & 31;
        const bf16_t* src = V + (size_t)(t * 32 + row) * 256 + ((chp ^ ((row & 3) << 2)) << 3);
        glds16(src, (unsigned)__builtin_amdgcn_readfirstlane((int)(unsigned)(uintptr_t)(lds + VBASE + slot * VSLOT + i * 1024))); }
}
#define DA_VADDR(i) (vq + (vb0 ^ (((i) & 3) << 6)) + ((((i) & 7) >> 2) * 256) + (16 * ((i) >> 3)) * 512)
__device__ __forceinline__ void pv_plain(f32x16 (&O)[8], const LAS unsigned char* vq, int vb0, bf16x8 pa0, bf16x8 pa1) {
    s16x4 vl[4], vh[4];
#pragma unroll
    for (int i = 0; i < 3; ++i) { vl[i] = trrd(DA_VADDR(i)); vh[i] = trrd(DA_VADDR(i) + 4096); }
    __builtin_amdgcn_sched_barrier(0);
#pragma unroll
    for (int i = 0; i < 16; ++i) {
        if (i + 3 < 16) { vl[(i + 3) & 3] = trrd(DA_VADDR(i + 3)); vh[(i + 3) & 3] = trrd(DA_VADDR(i + 3) + 4096); }
        O[i & 7] = MFMA32(i < 8 ? pa0 : pa1, cat4(vl[i & 3], vh[i & 3]), O[i & 7]);
        __builtin_amdgcn_sched_barrier(0);
    }
}
template <int VAR> __device__ __forceinline__ void unit(LAS unsigned char* lds, LAS float* wscr, const bf16_t* Q, const bf16_t* K, const bf16_t* V, const bf16_t* G, bf16_t* AO, const float* subg, float lam, float osc, int b, int h, int qb) {
    const int tid = threadIdx.x, lane = tid & 63, wid = __builtin_amdgcn_readfirstlane(tid >> 6), g = wid & 3, map = wid >> 2, r32 = lane & 31, hi = lane >> 5;
    const int q4 = (lane & 15) >> 2, p4 = lane & 3, blk = (lane >> 4) & 1;
    const bf16_t* K0 = K + (size_t)((b * 8 + h) * 2) * 8192 * 128; const bf16_t* K1 = K0 + (size_t)8192 * 128;
    const bf16_t* Vb = V + (size_t)(b * 8 + h) * 8192 * 256;
    const int qrow0 = qb * 128 + g * 32;
    const bf16_t* Qw = Q + ((size_t)((b * 8 + h) * 2 + map) * 8192 + qrow0) * 128;
    const int NT = 4 * qb + 4;
    issue_k(lds, 0, K0, K1, 0, wid, lane); issue_v(lds, 0, Vb, 0, wid, lane); issue_k(lds, 1, K0, K1, 1, wid, lane);
    bf16x8 qf[8];
#pragma unroll
    for (int d0 = 0; d0 < 8; ++d0) qf[d0] = *(const bf16x8*)(Qw + (size_t)r32 * 128 + d0 * 16 + hi * 8);
    f32x16 O[8];
#pragma unroll
    for (int n = 0; n < 8; ++n)
#pragma unroll
        for (int r = 0; r < 16; ++r) O[n][r] = 0.f;
    float mhat = -1e30f, lsum = 0.f;
    const int qabs = qrow0 + r32;
    const int vb0 = (4 * hi + q4) * 512 + (((4 * q4) + 2 * blk + (p4 >> 1)) << 4) + 8 * (p4 & 1);
    bf16x8 pa0, pa1;
#pragma unroll
    for (int j = 0; j < 8; ++j) { pa0[j] = 0; pa1[j] = 0; }
    int sl = 0, slp = 2;
    for (int t = 0; t < NT; ++t) {
        if (t + 2 < NT) asm volatile("s_waitcnt vmcnt(4)\n\ts_barrier" ::: "memory"); else asm volatile("s_waitcnt vmcnt(0)\n\ts_barrier" ::: "memory");
        if (t + 2 < NT) issue_k(lds, slp, K0, K1, t + 2, wid, lane);
        if (t + 1 < NT) issue_v(lds, (sl == 2 ? 0 : sl + 1), Vb, t + 1, wid, lane);
        if (VAR == 6) { slp = sl; sl = (sl == 2 ? 0 : sl + 1); continue; }
        const LAS unsigned char* kp = lds + sl * KSLOT + map * 8192 + hi * 512 + r32 * 16;
        const LAS unsigned char* vq = lds + VBASE + slp * VSLOT;
        f32x16 sc;
#pragma unroll
        for (int r = 0; r < 16; ++r) sc[r] = 0.f;
        { bf16x8 kf[2];
          kf[0] = *(const LAS bf16x8*)(kp);
          __builtin_amdgcn_sched_barrier(0);
#pragma unroll
          for (int d0 = 0; d0 < 8; ++d0) {
              if (d0 + 1 < 8) kf[(d0 + 1) & 1] = *(const LAS bf16x8*)(kp + (d0 + 1) * 1024);
              __builtin_amdgcn_s_setprio(1);
              sc = MFMA32(kf[d0 & 1], qf[d0], sc);
              __builtin_amdgcn_s_setprio(0); } }
        if (t >= 4 * qb) {
#pragma unroll
            for (int r = 0; r < 16; ++r) { const int kv = 32 * t + crow(r, hi); if (kv > qabs) sc[r] = -1e30f; }
        }
        float mx = fmaxf(fmaxf(sc[0], sc[1]), fmaxf(sc[2], sc[3]));
#pragma unroll
        for (int r = 4; r < 16; r += 4) mx = fmaxf(mx, fmaxf(fmaxf(sc[r], sc[r + 1]), fmaxf(sc[r + 2], sc[r + 3])));
        { auto rr = __builtin_amdgcn_permlane32_swap(__float_as_uint(mx), __float_as_uint(mx), false, false); mx = fmaxf(__uint_as_float(rr[0]), __uint_as_float(rr[1])); }
        float ls = 0.f;
        const bool resc = __any(mx > mhat + 8.0f);
        const float mnew = resc ? fmaxf(mhat, mx) : mhat, alpha = __builtin_amdgcn_exp2f(mhat - mnew);
        mhat = mnew;
        if (t == 0) {
#pragma unroll
            for (int r = 0; r < 16; ++r) { sc[r] = __builtin_amdgcn_exp2f(sc[r] - mhat); ls += sc[r]; }
        } else {
            s16x4 vl[3], vh[3];
#pragma unroll
            for (int i = 0; i < 2; ++i) { vl[i] = trrd(DA_VADDR(i)); vh[i] = trrd(DA_VADDR(i) + 4096); }
            __builtin_amdgcn_sched_barrier(0);
#pragma unroll
            for (int i = 0; i < 16; ++i) {
                if (i + 2 < 16) { vl[(i + 2) % 3] = trrd(DA_VADDR(i + 2)); vh[(i + 2) % 3] = trrd(DA_VADDR(i + 2) + 4096); }
                __builtin_amdgcn_s_setprio(1);
                if (VAR != 2) O[i & 7] = MFMA32(i < 8 ? pa0 : pa1, cat4(vl[i % 3], vh[i % 3]), O[i & 7]);
                __builtin_amdgcn_s_setprio(0);
                sc[i] = __builtin_amdgcn_exp2f(sc[i] - mhat); ls += sc[i];
                __builtin_amdgcn_sched_barrier(0);
            }
        }
        if (resc) {
            wscr[r32] = alpha;
#pragma unroll
            for (int gq = 0; gq < 4; ++gq) { const f32x4 a4 = *(const LAS f32x4*)(wscr + 8 * gq + 4 * hi);
#pragma unroll
                for (int n = 0; n < 8; ++n)
#pragma unroll
                    for (int e = 0; e < 4; ++e) O[n][4 * gq + e] *= a4[e]; }
        }
        lsum *= alpha;
        lsum += ls;
        pa0 = pack8(sc[0], sc[1], sc[2], sc[3], sc[4], sc[5], sc[6], sc[7]); pa1 = pack8(sc[8], sc[9], sc[10], sc[11], sc[12], sc[13], sc[14], sc[15]);
        slp = sl; sl = (sl == 2 ? 0 : sl + 1);
    }
    pv_plain(O, lds + VBASE + slp * VSLOT, vb0, pa0, pa1);
    lsum += __shfl_xor(lsum, 32);
    { const float f = (map == 0 ? 1.0f : lam) / lsum;
      wscr[r32] = f;
#pragma unroll
      for (int gq = 0; gq < 4; ++gq) { const f32x4 a4 = *(const LAS f32x4*)(wscr + 8 * gq + 4 * hi);
#pragma unroll
          for (int n = 0; n < 8; ++n)
#pragma unroll
              for (int e = 0; e < 4; ++e) O[n][4 * gq + e] *= a4[e]; } }
    __syncthreads();
    LAS float* xch = (LAS float*)(lds + g * 32768);
    if (map == 1) {
#pragma unroll
        for (int n = 0; n < 8; ++n)
#pragma unroll
            for (int r = 0; r < 16; ++r) xch[(n * 16 + r) * 64 + lane] = O[n][r];
    }
    __syncthreads();
    if (map == 0 && (VAR == 0 || lsum == 12345.678f)) {
        float ssq[16];
#pragma unroll
        for (int r = 0; r < 16; ++r) ssq[r] = 0.f;
#pragma unroll
        for (int n = 0; n < 8; ++n)
#pragma unroll
            for (int r = 0; r < 16; ++r) { O[n][r] -= xch[(n * 16 + r) * 64 + lane]; ssq[r] += O[n][r] * O[n][r]; }
#pragma unroll
        for (int r = 0; r < 16; ++r) {
#pragma unroll
            for (int o = 1; o < 32; o <<= 1) ssq[r] += __shfl_xor(ssq[r], o);
            ssq[r] = osc / sqrtf(ssq[r] * (1.0f / 256.0f) + 1e-6f);
        }
        const size_t tok0 = (size_t)b * 8192 + qrow0;
#pragma unroll
        for (int n = 0; n < 8; ++n) { const float sg = subg[32 * n + r32];
#pragma unroll
            for (int r = 0; r < 16; ++r) xch[crow(r, hi) * 256 + 32 * n + r32] = O[n][r] * ssq[r] * sg; }
        int lane2 = threadIdx.x & 63; asm volatile("" : "+v"(lane2));
#pragma unroll 4
        for (int i = 0; i < 16; ++i) { const int row = (lane2 >> 5) + 2 * i, c = lane2 & 31;
            const f32x4 v0 = *(const LAS f32x4*)(xch + row * 256 + c * 8), v1 = *(const LAS f32x4*)(xch + row * 256 + c * 8 + 4);
            const size_t idx = (tok0 + row) * 2048 + h * 256 + c * 8;
            const u32x4 gg = *(const u32x4*)(G + idx);
            u32x4 w; w.x = cvtpk(v0[0] * bflo(gg.x), v0[1] * bfhi(gg.x)); w.y = cvtpk(v0[2] * bflo(gg.y), v0[3] * bfhi(gg.y)); w.z = cvtpk(v1[0] * bflo(gg.z), v1[1] * bfhi(gg.z)); w.w = cvtpk(v1[2] * bflo(gg.w), v1[3] * bfhi(gg.w));
            *(u32x4*)(AO + idx) = w; }
    }
    __syncthreads();
}
#undef DA_VADDR
}

namespace swa {
__device__ __forceinline__ void unit(LAS unsigned char* lds, LAS float* wscr, const bf16_t* Q, const bf16_t* K, const bf16_t* V, const bf16_t* G, bf16_t* AO, const float* sinks, int b, int kvh, int nb) {
    const int tid = threadIdx.x, lane = tid & 63, wid = __builtin_amdgcn_readfirstlane(tid >> 6), r32 = lane & 31, hi = lane >> 5;
    const int q4 = (lane & 15) >> 2, p4 = lane & 3, blk = (lane >> 4) & 1;
    LAS unsigned char* Ks = lds; LAS unsigned char* Vs = lds + 32768;
    const bf16_t* Kg = K + (size_t)(b * 4 + kvh) * 8192 * 64; const bf16_t* Vg = V + (size_t)(b * 4 + kvh) * 8192 * 64;
#pragma unroll
    for (int i = 0; i < 4; ++i) { const int id = tid + 512 * i, row = id >> 3, ch = id & 7, kabs = 128 * (nb - 1) + row;
        u32x4 kv = (u32x4){0u, 0u, 0u, 0u}, vv = (u32x4){0u, 0u, 0u, 0u};
        if (kabs >= 0) { kv = *(const u32x4*)(Kg + (size_t)kabs * 64 + ch * 8); vv = *(const u32x4*)(Vg + (size_t)kabs * 64 + ch * 8); }
        *(LAS u32x4*)(Ks + off128k(row, ch)) = kv; *(LAS u32x4*)(Vs + off128v(row, ch)) = vv; }
    __syncthreads();
    const int head = kvh * 8 + wid;
    const float sk = sinks[head] * LOG2E;
    const bf16_t* Qh = Q + ((size_t)(b * 32 + head) * 8192 + nb * 128) * 64;
    for (int i = 0; i < 4; ++i) {
        bf16x8 qf[4];
#pragma unroll
        for (int d0 = 0; d0 < 4; ++d0) qf[d0] = *(const bf16x8*)(Qh + (size_t)(32 * i + r32) * 64 + d0 * 16 + hi * 8);
        f32x16 sc[5];
        const int qq = 128 + 32 * i + r32;
        float mx = sk;
#pragma unroll
        for (int jj = 0; jj < 5; ++jj) { const int j = i + jj;
#pragma unroll
            for (int r = 0; r < 16; ++r) sc[jj][r] = 0.f;
#pragma unroll
            for (int d0 = 0; d0 < 4; ++d0) { const bf16x8 kf = *(const LAS bf16x8*)(Ks + off128k(32 * j + r32, 2 * d0 + hi)); sc[jj] = MFMA32(kf, qf[d0], sc[jj]); }
            if (jj == 0 || jj == 4 || nb == 0) {
#pragma unroll
                for (int r = 0; r < 16; ++r) { const int kk = 32 * j + crow(r, hi); const bool ok = (kk <= qq) && (qq - kk < 128) && (nb > 0 || kk >= 128);
                    sc[jj][r] = ok ? sc[jj][r] : -1e30f; }
            }
#pragma unroll
            for (int r = 0; r < 16; ++r) mx = fmaxf(mx, sc[jj][r]);
        }
        mx = fmaxf(mx, __shfl_xor(mx, 32));
        float ls = 0.f;
#pragma unroll
        for (int jj = 0; jj < 5; ++jj)
#pragma unroll
            for (int r = 0; r < 16; ++r) { sc[jj][r] = __builtin_amdgcn_exp2f(sc[jj][r] - mx); ls += sc[jj][r]; }
        ls += __shfl_xor(ls, 32);
        ls += __builtin_amdgcn_exp2f(sk - mx);
        f32x16 O[2];
#pragma unroll
        for (int n = 0; n < 2; ++n)
#pragma unroll
            for (int r = 0; r < 16; ++r) O[n][r] = 0.f;
#pragma unroll
        for (int jj = 0; jj < 5; ++jj)
#pragma unroll
            for (int c = 0; c < 2; ++c) {
                const bf16x8 pa = pack8(sc[jj][8 * c + 0], sc[jj][8 * c + 1], sc[jj][8 * c + 2], sc[jj][8 * c + 3], sc[jj][8 * c + 4], sc[jj][8 * c + 5], sc[jj][8 * c + 6], sc[jj][8 * c + 7]);
                const int vr = 32 * (i + jj) + 16 * c + 4 * hi + q4;
#pragma unroll
                for (int n = 0; n < 2; ++n) { const int ch = 4 * n + 2 * blk + (p4 >> 1);
                    const s16x4 lo = trrd(Vs + off128v(vr, ch) + 8 * (p4 & 1)), hh = trrd(Vs + off128v(vr + 8, ch) + 8 * (p4 & 1));
                    O[n] = MFMA32(pa, cat4(lo, hh), O[n]); }
            }
        wscr[r32] = 1.0f / ls;
        f32x4 a4[4];
#pragma unroll
        for (int gq = 0; gq < 4; ++gq) a4[gq] = *(const LAS f32x4*)(wscr + 8 * gq + 4 * hi);
        const size_t tok0 = (size_t)b * 8192 + nb * 128 + 32 * i;
        LAS float* stg = (LAS float*)(lds + 65536 + wid * 8192);
#pragma unroll
        for (int n = 0; n < 2; ++n)
#pragma unroll
            for (int r = 0; r < 16; ++r) stg[crow(r, hi) * 64 + 32 * n + r32] = O[n][r] * a4[r >> 2][r & 3];
#pragma unroll
        for (int k4 = 0; k4 < 4; ++k4) { const int row = (lane >> 3) + 8 * k4, c = lane & 7;
            const f32x4 v0 = *(const LAS f32x4*)(stg + row * 64 + c * 8), v1 = *(const LAS f32x4*)(stg + row * 64 + c * 8 + 4);
            const size_t idx = (tok0 + row) * 2048 + head * 64 + c * 8;
            const u32x4 gg = *(const u32x4*)(G + idx);
            u32x4 w; w.x = cvtpk(v0[0] * bflo(gg.x), v0[1] * bfhi(gg.x)); w.y = cvtpk(v0[2] * bflo(gg.y), v0[3] * bfhi(gg.y)); w.z = cvtpk(v1[0] * bflo(gg.z), v1[1] * bfhi(gg.z)); w.w = cvtpk(v1[2] * bflo(gg.w), v1[3] * bfhi(gg.w));
            *(u32x4*)(AO + idx) = w; }
    }
    __syncthreads();
}
}

namespace ml {
__device__ __forceinline__ void gate_carry(float* sc, int bh, int lane) {
    const float a0 = sc[SC_BLC + bh * 128 + lane], a1 = sc[SC_BLC + bh * 128 + 64 + lane], c0 = sc[SC_CML + bh * 128 + lane], c1 = sc[SC_CML + bh * 128 + 64 + lane];
    float m = 0.f, segsum = 0.f, mstart = 0.f;
    for (int c = 0; c < 128; ++c) {
        const int l = c & 63;
        const float bL = __uint_as_float(__builtin_amdgcn_readlane(__float_as_uint(c < 64 ? a0 : a1), l)), cmL = __uint_as_float(__builtin_amdgcn_readlane(__float_as_uint(c < 64 ? c0 : c1), l));
        if (lane == 0) sc[SC_MC + bh * 129 + c] = m;
        const float mnew = bL + fmaxf(m, cmL);
        segsum += bL;
        if ((c & 7) == 7) { if (lane == 0) sc[SC_SD + bh * 16 + (c >> 3)] = expf(segsum + mstart - mnew); segsum = 0.f; mstart = mnew; }
        m = mnew;
    }
    if (lane == 0) sc[SC_MC + bh * 129 + 128] = m;
}
constexpr int L_Q = 0, L_K = 16384, L_V = 32768, L_VW = 65536, L_A = 98304, L_SC = 106496, L_H = 110592, HROW = 520;
__device__ __forceinline__ void store_h(const LAS unsigned char* lds, bf16_t* hs0, int tid) {
#pragma unroll
    for (int i = 0; i < 4; ++i) { const int id = tid + 512 * i, row = id >> 5, c16 = id & 31;
        const u32x2 lo = *(const LAS u32x2*)(lds + L_H + row * HROW + c16 * 16), hi2 = *(const LAS u32x2*)(lds + L_H + row * HROW + c16 * 16 + 8);
        *(u32x4*)(hs0 + (size_t)row * 2048 + c16 * 8) = (u32x4){lo.x, lo.y, hi2.x, hi2.y}; }
}
template <bool FULL, int VAR = 0> __device__ __forceinline__ void seg_pass(LAS unsigned char* lds, const bf16_t* Q, const bf16_t* K, const bf16_t* V, const float* sc, float* Est, float* En, bf16_t* HS, int bh, int seg) {
    int tid = threadIdx.x; asm volatile("" : "+v"(tid));
    const int lane = tid & 63, wid = __builtin_amdgcn_readfirstlane(tid >> 6), r32 = lane & 31, hi = lane >> 5;
    const int q4 = (lane & 15) >> 2, p4 = lane & 3, blk = (lane >> 4) & 1;
    const int b = bh >> 3, h = bh & 7;
    LAS float* sbl = (LAS float*)(lds + L_SC); LAS float* sii = sbl + 64; LAS float* smt = sbl + 128; LAS float* swk = sbl + 192; LAS float* rows = sbl + 256; LAS float* nq = sbl + 384; LAS float* nvec = sbl + 448;
    const bf16_t* Qg = Q + (size_t)bh * 8192 * 128; const bf16_t* Kg = K + (size_t)bh * 8192 * 128; const bf16_t* Vg = V + (size_t)bh * 8192 * 256;
    const float* gbl = sc + SC_BL + bh * 8192; const float* gii = sc + SC_II + bh * 8192; const float* gmt = sc + SC_MT + bh * 8192; const float* gmc = sc + SC_MC + bh * 129;
    f32x16 CT[4];
    float* Eb = Est + (size_t)(bh * 16 + seg) * 32768 + (size_t)(wid * 4) * 1024;
    if (FULL) {
        const float* e = Eb + lane;
#pragma unroll
        for (int dt = 0; dt < 4; ++dt) {
#pragma unroll
            for (int r = 0; r < 16; ++r) CT[dt][r] = e[r * 64];
            e += 1024; asm volatile("" : "+v"(e)); }
        if (tid < 128) nvec[tid] = En[(size_t)(bh * 16 + seg) * 128 + tid];
    } else {
#pragma unroll
        for (int dt = 0; dt < 4; ++dt)
#pragma unroll
            for (int r = 0; r < 16; ++r) CT[dt][r] = 0.f;
        if (tid < 128) nvec[tid] = 0.f;
    }
    for (int cc = 0; cc < 8; ++cc) {
        const int c = seg * 8 + cc, t0 = 64 * c;
        const float m_in = gmc[c], m_out = gmc[c + 1], bL = gbl[t0 + 63];
        __syncthreads();
        if (FULL && cc > 0) store_h(lds, HS + ((size_t)b * 8192 + t0 - 64) * 2048 + h * 256, tid);
        if (VAR != 2 || cc == 0) {
#pragma unroll
        for (int i = 0; i < 2; ++i) { const int id = tid + 512 * i, row = id >> 4, ch = id & 15;
            if (FULL) *(LAS u32x4*)(lds + L_Q + off256(row, ch)) = *(const u32x4*)(Qg + (size_t)(t0 + row) * 128 + ch * 8);
            *(LAS u32x4*)(lds + L_K + off256(row, ch)) = *(const u32x4*)(Kg + (size_t)(t0 + row) * 128 + ch * 8); }
#pragma unroll
        for (int i = 0; i < 4; ++i) { const int id = lane + 64 * i, row = id >> 2, cq = id & 3;
            const u32x4 vv = *(const u32x4*)(Vg + (size_t)(t0 + row) * 256 + wid * 32 + cq * 8);
            const float wk = __expf(bL - gbl[t0 + row] + gii[t0 + row] - m_out);
            u32x4 vw; vw.x = cvtpk(bflo(vv.x) * wk, bfhi(vv.x) * wk); vw.y = cvtpk(bflo(vv.y) * wk, bfhi(vv.y) * wk); vw.z = cvtpk(bflo(vv.z) * wk, bfhi(vv.z) * wk); vw.w = cvtpk(bflo(vv.w) * wk, bfhi(vv.w) * wk);
            if (FULL) *(LAS u32x4*)(lds + L_V + off512(row, 4 * wid + cq)) = vv;
            *(LAS u32x4*)(lds + L_VW + off512(row, 4 * wid + cq)) = vw; }
        if (tid < 64) { const float bl_ = gbl[t0 + tid], ii_ = gii[t0 + tid]; sbl[tid] = bl_; sii[tid] = ii_; smt[tid] = bl_ + fmaxf(m_in, gmt[t0 + tid]); swk[tid] = __expf(bL - bl_ + ii_ - m_out); }
        }
        __syncthreads();
        __builtin_amdgcn_sched_barrier(0);
        if (FULL) {
            if (wid < 4) {
                const int st = wid >> 1, tt = wid & 1, t = 32 * tt + r32;
                f32x16 s;
#pragma unroll
                for (int r = 0; r < 16; ++r) s[r] = 0.f;
                if (!(st == 1 && tt == 0)) {
#pragma unroll
                    for (int d0 = 0; d0 < 8; ++d0) { const bf16x8 kf = *(const LAS bf16x8*)(lds + L_K + off256(32 * st + r32, 2 * d0 + hi)); const bf16x8 qv = *(const LAS bf16x8*)(lds + L_Q + off256(t, 2 * d0 + hi)); s = MFMA32(kf, qv, s); }
                }
                const float sat = sbl[t] - smt[t];
                float rs = 0.f;
#pragma unroll
                for (int gq = 0; gq < 4; ++gq) { const int s0 = 32 * st + 8 * gq + 4 * hi;
                    const f32x4 bi = *(const LAS f32x4*)(sii + s0), bb = *(const LAS f32x4*)(sbl + s0);
                    float a[4];
#pragma unroll
                    for (int e = 0; e < 4; ++e) { const float w = (s0 + e <= t) ? __expf(sat + bi[e] - bb[e]) : 0.f; a[e] = s[4 * gq + e] * w; rs += a[e]; }
                    u32x2 pk; pk.x = cvtpk(a[0], a[1]); pk.y = cvtpk(a[2], a[3]);
                    *(LAS u32x2*)(lds + L_A + off128k(t, 4 * st + gq) + 8 * hi) = pk; }
                rs += __shfl_xor(rs, 32);
                if (hi == 0) rows[st * 64 + t] = rs;
            } else {
                const int idx = tid - 256, t = idx >> 2, part = idx & 3; float p = 0.f;
#pragma unroll
                for (int c4 = 0; c4 < 4; ++c4) { const u32x4 qv = *(const LAS u32x4*)(lds + L_Q + off256(t, 4 * part + c4)); const LAS float* nv = nvec + 32 * part + 8 * c4;
                    p += bflo(qv.x) * nv[0] + bfhi(qv.x) * nv[1] + bflo(qv.y) * nv[2] + bfhi(qv.y) * nv[3] + bflo(qv.z) * nv[4] + bfhi(qv.z) * nv[5] + bflo(qv.w) * nv[6] + bfhi(qv.w) * nv[7]; }
                p += __shfl_xor(p, 1); p += __shfl_xor(p, 2);
                if (part == 0) nq[t] = p;
            }
            __syncthreads();
            __builtin_amdgcn_sched_barrier(0);
#pragma unroll 1
            for (int tt = 0; tt < 2; ++tt) {
                const int t = 32 * tt + r32;
                f32x16 acc;
#pragma unroll
                for (int r = 0; r < 16; ++r) acc[r] = 0.f;
#pragma unroll
                for (int dt = 0; dt < 4; ++dt)
#pragma unroll
                    for (int c2 = 0; c2 < 2; ++c2) {
                        const bf16x8 A = pack8(CT[dt][8 * c2 + 0], CT[dt][8 * c2 + 1], CT[dt][8 * c2 + 2], CT[dt][8 * c2 + 3], CT[dt][8 * c2 + 4], CT[dt][8 * c2 + 5], CT[dt][8 * c2 + 6], CT[dt][8 * c2 + 7]);
                        const s16x4 lo = *(const LAS s16x4*)(lds + L_Q + off256(t, 4 * dt + 2 * c2) + 8 * hi), hh = *(const LAS s16x4*)(lds + L_Q + off256(t, 4 * dt + 2 * c2 + 1) + 8 * hi);
                        acc = MFMA32(A, cat4(lo, hh), acc);
                    }
                const float wi = __expf(sbl[t] + m_in - smt[t]);
#pragma unroll
                for (int r = 0; r < 16; ++r) acc[r] *= wi;
#pragma unroll 1
                for (int cs = 0; cs < 4; ++cs) { const int vr = 16 * cs + 8 * hi + q4, ch = 4 * wid + 2 * blk + (p4 >> 1);
                    const s16x4 lo = trrd(lds + L_V + off512(vr, ch) + 8 * (p4 & 1)), hh = trrd(lds + L_V + off512(vr + 4, ch) + 8 * (p4 & 1));
                    const bf16x8 B = *(const LAS bf16x8*)(lds + L_A + off128k(t, 2 * cs + hi));
                    acc = MFMA32(cat4(lo, hh), B, acc); }
                const float dn = rows[t] + rows[64 + t] + wi * nq[t];
                const float inv = 1.0f / fmaxf(fabsf(dn), __expf(-smt[t]));
#pragma unroll
                for (int gq = 0; gq < 4; ++gq) { u32x2 pk; pk.x = cvtpk(acc[4 * gq] * inv, acc[4 * gq + 1] * inv); pk.y = cvtpk(acc[4 * gq + 2] * inv, acc[4 * gq + 3] * inv);
                    *(LAS u32x2*)(lds + L_H + t * HROW + (wid * 32 + 8 * gq + 4 * hi) * 2) = pk; }
            }
        }
        __builtin_amdgcn_sched_barrier(0);
        const float decay = __expf(bL + m_in - m_out);
#pragma unroll
        for (int dt = 0; dt < 4; ++dt)
#pragma unroll
            for (int r = 0; r < 16; ++r) CT[dt][r] *= decay;
#pragma unroll 1
        for (int cs = 0; cs < 4; ++cs) { const int vr = 16 * cs + 8 * hi + q4, chv = 4 * wid + 2 * blk + (p4 >> 1);
            const s16x4 bl0 = trrd(lds + L_VW + off512(vr, chv) + 8 * (p4 & 1)), bh0 = trrd(lds + L_VW + off512(vr + 4, chv) + 8 * (p4 & 1));
            const bf16x8 B = cat4(bl0, bh0);
#pragma unroll
            for (int dt = 0; dt < 4; ++dt) { const int chk = 4 * dt + 2 * blk + (p4 >> 1);
                const s16x4 al = trrd(lds + L_K + off256(vr, chk) + 8 * (p4 & 1)), ah = trrd(lds + L_K + off256(vr + 4, chk) + 8 * (p4 & 1));
                CT[dt] = MFMA32(cat4(al, ah), B, CT[dt]); } }
        if (wid >= 4) {
            const int idx = tid - 256, d = idx >> 1, half = idx & 1; float p = 0.f;
#pragma unroll 8
            for (int s = 0; s < 32; ++s) { const int sr = 32 * half + s; p += swk[sr] * bf2f(*(const LAS unsigned short*)(lds + L_K + off256(sr, d >> 3) + 2 * (d & 7))); }
            p += __shfl_xor(p, 1);
            if (half == 0) nvec[d] = decay * nvec[d] + p;
        }
    }
    if (FULL) { __syncthreads(); store_h(lds, HS + ((size_t)b * 8192 + (seg * 8 + 7) * 64) * 2048 + h * 256, tid); }
    if (!FULL) {
#pragma unroll
        for (int dt = 0; dt < 4; ++dt)
#pragma unroll
            for (int r = 0; r < 16; ++r) Eb[(dt * 16 + r) * 64 + lane] = CT[dt][r];
        __syncthreads();
        if (tid < 128) En[(size_t)(bh * 16 + seg) * 128 + tid] = nvec[tid];
    }
    __syncthreads();
}
__device__ __forceinline__ void seg_scan(float* Est, float* En, const float* sc, int gtid, int ngt) {
    for (int e = gtid; e < 16 * (32768 + 128); e += ngt) {
        const int bh = e / (32768 + 128), i = e - bh * (32768 + 128);
        float* p = (i < 32768) ? Est + (size_t)bh * 16 * 32768 + i : En + (size_t)bh * 16 * 128 + (i - 32768);
        const size_t stride = (i < 32768) ? 32768 : 128;
        float run = 0.f;
        for (int sg = 0; sg < 16; ++sg) { const float tmp = p[sg * stride]; p[sg * stride] = run; run = sc[SC_SD + bh * 16 + sg] * run + tmp; }
    }
}
__device__ __forceinline__ void finalize(bf16_t* HS, const bf16_t* SO, const bf16_t* SG, const float* ng, int gw, int NGW, int lane) {
    const f32x4 gv = ((const f32x4*)ng)[lane];
    for (int row = gw; row < TOK; row += NGW) {
        u32x2* hp = (u32x2*)(HS + (size_t)row * DM) + lane; const u32x2* op = (const u32x2*)(SO + (size_t)row * DM) + lane; const u32x2* gp = (const u32x2*)(SG + (size_t)row * DM) + lane;
#pragma unroll
        for (int j = 0; j < 8; ++j) { const u32x2 hv = hp[64 * j], ov = op[64 * j], sg = gp[64 * j];
            const float x0 = bflo(hv.x), x1 = bfhi(hv.x), x2 = bflo(hv.y), x3 = bfhi(hv.y);
            const float r = 1.0f / sqrtf(wave_sum((x0 * x0 + x1 * x1) + (x2 * x2 + x3 * x3)) * (1.0f / 256.0f) + 1e-6f);
            u32x2 w; w.x = cvtpk(x0 * r * gv.x * bflo(ov.x) * bflo(sg.x), x1 * r * gv.y * bfhi(ov.x) * bfhi(sg.x)); w.y = cvtpk(x2 * r * gv.z * bflo(ov.y) * bflo(sg.y), x3 * r * gv.w * bfhi(ov.y) * bfhi(sg.y));
            hp[64 * j] = w; }
    }
}
}
#define XB_TMO      128
#define XB_XCNT(j)  (256  + 64 * (j))
#define XB_XSUB(j)  (1280 + 64 * (j))
#define XB_XGEN(j)  (2304 + 64 * (j))
#define XB_TOP      3328
#define XB_TOPGEN   3392
#define XCD_BAR_WORDS 3456
#define XB_SPIN_CAP (1u << 18)

__device__ __forceinline__ unsigned xb_ld(unsigned* p)              { return __hip_atomic_load(p, __ATOMIC_RELAXED, __HIP_MEMORY_SCOPE_AGENT); }
__device__ __forceinline__ unsigned xb_add(unsigned* p, unsigned v) { return __hip_atomic_fetch_add(p, v, __ATOMIC_RELAXED, __HIP_MEMORY_SCOPE_AGENT); }
__device__ __forceinline__ unsigned xb_xcc_id() { return (unsigned)__builtin_amdgcn_s_getreg((3 << 11) | 20) & 0xFu; }
#define XB_SPIN(cond, bar) do { unsigned _sp = 0; while (cond) { __builtin_amdgcn_s_sleep(1); \
    if ((++_sp & 255u) == 0u) { if (xb_ld(&(bar)[XB_TMO])) break; if (_sp > XB_SPIN_CAP) { atomicAdd(&(bar)[XB_TMO], 1u); break; } } } } while (0)

struct XcdBarrier {
    unsigned* bar; unsigned x;
    volatile LAS unsigned* st;
};

__device__ __forceinline__ XcdBarrier xcd_barrier_post(unsigned* bar, volatile LAS unsigned* st) {
    XcdBarrier b; b.bar = bar; b.x = xb_xcc_id(); b.st = st;
    if (threadIdx.x == 0) (void)xb_add(&bar[XB_XCNT(b.x)], 1u);
    return b;
}
__device__ __forceinline__ void xcd_barrier_complete(unsigned* bar, unsigned x, unsigned& nloc, unsigned& nx) {
    const unsigned G = gridDim.x * gridDim.y * gridDim.z;
    unsigned sum, cnt, mine, sp = 0u;
    for (;;) {
        sum = 0u; cnt = 0u; mine = 0u;
#pragma unroll
        for (unsigned j = 0; j < 16; ++j) { const unsigned c = xb_ld(&bar[XB_XCNT(j)]); sum += c; cnt += (c > 0u) ? 1u : 0u; mine = (j == x) ? c : mine; }
        if (sum == G) break;
        __builtin_amdgcn_s_sleep(1);
        if ((++sp & 255u) == 0u) { if (xb_ld(&bar[XB_TMO])) break; if (sp > XB_SPIN_CAP) { atomicAdd(&bar[XB_TMO], 1u); break; } }
    }
    nloc = mine > 0u ? mine : 1u; nx = cnt > 0u ? cnt : 1u;
}

__device__ __forceinline__ void xcd_barrier(const XcdBarrier& b) {
    asm volatile("s_waitcnt vmcnt(0)" ::: "memory");
    __syncthreads();
    if (threadIdx.x == 0) {
        unsigned* bar = b.bar;
        __builtin_amdgcn_s_waitcnt(0);
        unsigned nloc = b.st[0], nx = b.st[1];
        if (nloc == 0u) { xcd_barrier_complete(bar, b.x, nloc, nx); b.st[0] = nloc; b.st[1] = nx; }
        const unsigned old = xb_add(&bar[XB_XSUB(b.x)], 1u);
        const unsigned gen = old / nloc;
        if (old + 1u == (gen + 1u) * nloc) {
            __builtin_amdgcn_fence(__ATOMIC_RELEASE, "agent");
            asm volatile("s_waitcnt vmcnt(0)" ::: "memory");
            const unsigned og = xb_add(&bar[XB_TOP], 1u);
            const unsigned tg = og / nx;
            if (og + 1u == (tg + 1u) * nx) xb_add(&bar[XB_TOPGEN], 1u);
            else XB_SPIN(xb_ld(&bar[XB_TOPGEN]) == tg, bar);
            __builtin_amdgcn_fence(__ATOMIC_ACQUIRE, "agent");
            xb_add(&bar[XB_XGEN(b.x)], 1u);
            asm volatile("s_waitcnt vmcnt(0)" ::: "memory");
        } else {
            XB_SPIN(xb_ld(&bar[XB_XGEN(b.x)]) == gen, bar);
            __builtin_amdgcn_fence(__ATOMIC_ACQUIRE, "agent");
            asm volatile("s_waitcnt vmcnt(0)" ::: "memory");
        }
    }
    __syncthreads();
}

struct Args {
    const float* x; const int* pos; const float* norm_g; const float* final_g;
    const float* da_w_in; const float* da_w_out; const float* da_lambda; const float* da_subln;
    const float* sw_w_in; const float* sw_w_out; const float* sw_sinks;
    const float* ml_w_in; const float* ml_b_gates; const float* ml_w_out; const float* ml_norm_g;
    float* out; unsigned char* ws; int ph_lo, ph_hi;
};
#ifndef PROBE_EXTRA
#define PROBE_EXTRA 0
#endif
constexpr int N_PHASES = 20 + PROBE_EXTRA;
#ifndef MK_LAUNCHES
#define MK_LAUNCHES 1
#endif

__device__ __forceinline__ float da_lambda_full(const float* lam, float lambda_init, int lane) {
    float a = lam[lane] * lam[128 + lane] + lam[64 + lane] * lam[128 + 64 + lane];
    float c = lam[256 + lane] * lam[384 + lane] + lam[256 + 64 + lane] * lam[384 + 64 + lane];
    a = wave_sum(a); c = wave_sum(c);
    return expf(a) - expf(c) + lambda_init;
}

__global__ void __launch_bounds__(512, 2) hybrid_fwd(Args args) {
    extern __shared__ __attribute__((aligned(16))) unsigned char lds_raw[];
    LAS unsigned char* lds = (LAS unsigned char*)lds_raw;
    cg::grid_group grid = cg::this_grid();
    const int tid0 = threadIdx.x, wave = __builtin_amdgcn_readfirstlane(tid0 >> 6);
    const int G = gridDim.x, bx = blockIdx.x, vcu = (G % 8 == 0) ? (bx % 8) * (G / 8) + bx / 8 : bx;
    const int gw = vcu * NWAVES + wave, NGW = G * NWAVES, ngt = G * 512;
    unsigned char* ws = args.ws;
    bf16_t* HN = (bf16_t*)(ws + WS_HN); bf16_t* ACT = (bf16_t*)(ws + WS_ACT);
    float* SCN = (float*)(ws + WS_SCAN); float* GIF = (float*)(ws + WS_GIF);
    LAS float* wscr = (LAS float*)(lds + MISC_OFF) + wave * 64;
    (void)gw; (void)ngt;
    const int lo = args.ph_lo, hi = args.ph_hi;
    volatile LAS unsigned* xb_st = (volatile LAS unsigned*)(lds + LDS_BYTES - 16);
    if (tid0 < 2) xb_st[tid0] = 0u;
    __syncthreads();
    XcdBarrier xbar = xcd_barrier_post((unsigned*)(ws + 4096), xb_st);
    if (args.ph_lo == 0x7fffffff) grid.sync();
    int ph = 0;
#ifndef PROBE_MLV
#define PROBE_MLV 0
#endif
#ifndef PROBE_REP
#define PROBE_REP 0u
#endif
#ifndef PH_MASK
#define PH_MASK 0xFFFFFFFu
#endif
#define PHASE_BEGIN if (((PH_MASK >> ph) & 1u) && ph >= lo && ph < hi) { int tid = tid0; asm volatile("" : "+v"(tid)); const int lane = tid & 63, gtid = vcu * 512 + tid; (void)lane; (void)gtid;
#define PHASE_END   if (ph + 1 < hi) xcd_barrier(xbar); } ++ph;

    PHASE_BEGIN
        LAS float* scr = (LAS float*)(lds + wave * 16640);
        { constexpr int I_IN = 32 * 128, I_OUT = 32 * 32, I_SW = 32 * 72;
          const CvMat ma{args.da_w_in, (bf16_t*)(ws + WS_W_DA0_IN), 8192, 8192, 1}, mb{args.sw_w_in, (bf16_t*)(ws + WS_W_SW_IN), 4608, 4608, 2},
                      mc{args.da_w_out, (bf16_t*)(ws + WS_W_DA0_OUT), 2048, 2048, 0}, md{args.sw_w_out, (bf16_t*)(ws + WS_W_SW_OUT), 2048, 2048, 0};
          convert_set(ma, mb, mc, md, I_IN, I_SW, I_OUT, I_OUT, gw, NGW, scr, lane); }
        rope_table(args.pos, 64, (float*)(ws + WS_ROPEA_C), (float*)(ws + WS_ROPEA_S), gtid, ngt);
        rope_table(args.pos, 32, (float*)(ws + WS_ROPEB_C), (float*)(ws + WS_ROPEB_S), gtid, ngt);
        norm_rows<false>(args.x, args.norm_g, HN, gw, NGW, lane, nullptr, nullptr, nullptr);
    PHASE_END
#ifdef PROBE_P0
    PHASE_BEGIN
        LAS float* scr = (LAS float*)(lds + wave * 16640);
        { constexpr int I_IN = 32 * 128, I_OUT = 32 * 32, I_SW = 32 * 72;
          const CvMat ma{args.da_w_in, (bf16_t*)(ws + WS_W_DA0_IN), 8192, 8192, 1}, mb{args.sw_w_in, (bf16_t*)(ws + WS_W_SW_IN), 4608, 4608, 2},
                      mc{args.da_w_out, (bf16_t*)(ws + WS_W_DA0_OUT), 2048, 2048, 0}, md{args.sw_w_out, (bf16_t*)(ws + WS_W_SW_OUT), 2048, 2048, 0};
          convert_set(ma, mb, mc, md, I_IN, I_SW, I_OUT, I_OUT, gw, NGW, scr, lane); }
        rope_table(args.pos, 64, (float*)(ws + WS_ROPEA_C), (float*)(ws + WS_ROPEA_S), gtid, ngt);
        rope_table(args.pos, 32, (float*)(ws + WS_ROPEB_C), (float*)(ws + WS_ROPEB_S), gtid, ngt);
        norm_rows<false>(args.x, args.norm_g, HN, gw, NGW, lane, nullptr, nullptr, nullptr);
    PHASE_END
#endif

#define GEMM_IN(KIND, WOFF, NCOLS, COST, SINT) GEMM_IN2(KIND, WOFF, NCOLS, COST, SINT, 0)
#define GEMM_IN2(KIND, WOFF, NCOLS, COST, SINT, SKIP) do { asm volatile("s_waitcnt vmcnt(0)" ::: "memory"); \
        pg8::Gemm g_{HN, (const bf16_t*)(ws + (WOFF)), TOK, (NCOLS), 2048}; pg8::StaticOrder S_; S_.init(TOK, (NCOLS), G, bx); \
        pg8::EpiProj E_{(KIND), ACT, (const float*)(ws + (COST)), (const float*)(ws + (SINT)), (SKIP)}; \
        pg8::gemm_phase<pg8::EpiProj, pg8::StaticOrder, true, true>(lds, g_, S_, E_); } while (0)
#define GEMM_OUT(WOFF, XIN) do { asm volatile("s_waitcnt vmcnt(0)" ::: "memory"); \
        pg8::Gemm g_{HN, (const bf16_t*)(ws + (WOFF)), TOK, 2048, 2048}; pg8::StaticOrder S_; S_.init(TOK, 2048, G, bx); \
        pg8::EpiRes E_{(XIN), args.out}; \
        pg8::gemm_phase<pg8::EpiRes, pg8::StaticOrder, true, true>(lds, g_, S_, E_); } while (0)
#define DA_ATTN(LAYER_J, LAMBDA_INIT, VARIANT) do { \
        const float lamf_ = da_lambda_full(args.da_lambda + (LAYER_J) * 512, (LAMBDA_INIT), lane); \
        for (int idx_ = vcu; idx_ < 1024; idx_ += G) { const int rnd_ = idx_ >> 8, w_ = idx_ & 255, bh_ = w_ >> 4, s_ = w_ & 15; \
            const int qb_ = rnd_ == 0 ? 63 - s_ : rnd_ == 1 ? 32 + s_ : rnd_ == 2 ? 31 - s_ : s_; \
            da::unit<VARIANT>(lds, wscr, ACT, ACT + 32 * pg8::ACT_MiB, ACT + 64 * pg8::ACT_MiB, ACT + 96 * pg8::ACT_MiB, HN, args.da_subln + (LAYER_J) * 256, lamf_, 1.0f - (LAMBDA_INIT), bh_ >> 3, bh_ & 7, qb_); } } while (0)

    PHASE_BEGIN GEMM_IN(0, WS_W_DA0_IN, 8192, WS_ROPEA_C, WS_ROPEA_S); PHASE_END
#ifdef PROBE_GEMM
    PHASE_BEGIN GEMM_IN2(0, WS_W_DA0_IN, 8192, WS_ROPEA_C, WS_ROPEA_S, PROBE_GEMM - 1); PHASE_END
#endif
    PHASE_BEGIN DA_ATTN(0, 0.2f, 0); PHASE_END
#ifdef PROBE_ATTN
    PHASE_BEGIN DA_ATTN(0, 0.2f, PROBE_ATTN); PHASE_END
#endif
    PHASE_BEGIN GEMM_OUT(WS_W_DA0_OUT, args.x); PHASE_END
    PHASE_BEGIN norm_rows<false>(args.out, args.norm_g + 2048, HN, gw, NGW, lane, nullptr, nullptr, nullptr); PHASE_END
#ifdef PROBE_NORM
    PHASE_BEGIN norm_rows<false>(args.out, args.norm_g + 2048, HN, gw, NGW, lane, nullptr, nullptr, nullptr); PHASE_END
#endif
#ifdef PROBE_SYNC
    for (int i_ = 0; i_ < 20; ++i_) grid.sync();
#endif
    PHASE_BEGIN
        GEMM_IN(1, WS_W_SW_IN, 4608, WS_ROPEB_C, WS_ROPEB_S);
        if (bx >= G / 2) {
            LAS float* scr = (LAS float*)(lds + wave * 16640);
            constexpr int I_IN = 32 * 128, I_OUT = 32 * 32;
            const int gw2 = (bx - G / 2) * NWAVES + wave, NGW2 = (G - G / 2) * NWAVES;
            const CvMat ma{args.ml_w_in, (bf16_t*)(ws + WS_W_ML_IN), 8208, 8192, 3}, mb{args.da_w_in + (size_t)2048 * 8192, (bf16_t*)(ws + WS_W_DA1_IN), 8192, 8192, 1},
                        mc{args.ml_w_out, (bf16_t*)(ws + WS_W_ML_OUT), 2048, 2048, 0}, md{args.da_w_out + (size_t)2048 * 2048, (bf16_t*)(ws + WS_W_DA1_OUT), 2048, 2048, 0};
            convert_set(ma, mb, mc, md, I_IN, I_IN, I_OUT, I_OUT, gw2, NGW2, scr, lane);
        }
    PHASE_END
    PHASE_BEGIN
        for (int u = vcu; u < 512; u += G) swa::unit(lds, wscr, ACT, ACT + 32 * pg8::ACT_MiB, ACT + 36 * pg8::ACT_MiB, ACT + 96 * pg8::ACT_MiB, HN, args.sw_sinks, u >> 8, (u >> 6) & 3, u & 63);
    PHASE_END
#ifdef PROBE_SWA
    PHASE_BEGIN
        for (int u = vcu; u < 512; u += G) swa::unit(lds, wscr, ACT, ACT + 32 * pg8::ACT_MiB, ACT + 36 * pg8::ACT_MiB, ACT + 96 * pg8::ACT_MiB, HN, args.sw_sinks, u >> 8, (u >> 6) & 3, u & 63);
    PHASE_END
#endif
    PHASE_BEGIN GEMM_OUT(WS_W_SW_OUT, args.out); PHASE_END
    PHASE_BEGIN
        { LAS float* wg = (LAS float*)lds;
          for (int i = tid; i < 2048 * 16; i += 512) { const int k = i >> 4, j = i & 15; wg[j * 2048 + k] = args.ml_w_in[(size_t)k * 8208 + 6144 + j]; }
          __syncthreads();
          for (int cidx = vcu; cidx < 256; cidx += G) norm_gif_chunk(args.out, args.norm_g + 2 * 2048, HN, wg, (LAS float*)(lds + MISC_OFF + 4096), args.ml_b_gates, SCN, cidx, wave, lane); }
    PHASE_END
    PHASE_BEGIN
        if (vcu < 16 && wave == 0) ml::gate_carry(SCN, vcu, lane);
        GEMM_IN(2, WS_W_ML_IN, 8192, WS_ROPEA_C, WS_ROPEA_S);
    PHASE_END
    PHASE_BEGIN
        for (int u = vcu; u < 256; u += G) ml::seg_pass<false>(lds, ACT, ACT + 16 * pg8::ACT_MiB, ACT + 32 * pg8::ACT_MiB, SCN, (float*)(ws + WS_MLSTATE), (float*)(ws + WS_MLN), HN, u >> 4, u & 15);
    PHASE_END
#if defined(PROBE_ML) && PROBE_ML != 3
    PHASE_BEGIN
        for (int u = vcu; u < 256; u += G) ml::seg_pass<false>(lds, ACT, ACT + 16 * pg8::ACT_MiB, ACT + 32 * pg8::ACT_MiB, SCN, (float*)(ws + WS_MLSTATE), (float*)(ws + WS_MLN), HN, u >> 4, u & 15);
    PHASE_END
#endif
    PHASE_BEGIN ml::seg_scan((float*)(ws + WS_MLSTATE), (float*)(ws + WS_MLN), SCN, gtid, ngt); PHASE_END
    PHASE_BEGIN
        for (int u = vcu; u < 256; u += G) ml::seg_pass<true>(lds, ACT, ACT + 16 * pg8::ACT_MiB, ACT + 32 * pg8::ACT_MiB, SCN, (float*)(ws + WS_MLSTATE), (float*)(ws + WS_MLN), HN, u >> 4, u & 15);
    PHASE_END
#if defined(PROBE_ML) && PROBE_ML != 2
    PHASE_BEGIN
        for (int u = vcu; u < 256; u += G) ml::seg_pass<true, PROBE_MLV>(lds, ACT, ACT + 16 * pg8::ACT_MiB, ACT + 32 * pg8::ACT_MiB, SCN, (float*)(ws + WS_MLSTATE), (float*)(ws + WS_MLN), HN, u >> 4, u & 15);
    PHASE_END
#endif
    PHASE_BEGIN ml::finalize(HN, ACT + 64 * pg8::ACT_MiB, ACT + 96 * pg8::ACT_MiB, args.ml_norm_g, gw, NGW, lane); PHASE_END
    PHASE_BEGIN GEMM_OUT(WS_W_ML_OUT, args.out); PHASE_END
    PHASE_BEGIN norm_rows<false>(args.out, args.norm_g + 3 * 2048, HN, gw, NGW, lane, nullptr, nullptr, nullptr); PHASE_END
#ifdef PROBE_NORM
    PHASE_BEGIN norm_rows<false>(args.out, args.norm_g + 3 * 2048, HN, gw, NGW, lane, nullptr, nullptr, nullptr); PHASE_END
#endif
    PHASE_BEGIN GEMM_IN(0, WS_W_DA1_IN, 8192, WS_ROPEA_C, WS_ROPEA_S); PHASE_END
#ifdef PROBE_GEMM
    PHASE_BEGIN GEMM_IN2(0, WS_W_DA1_IN, 8192, WS_ROPEA_C, WS_ROPEA_S, PROBE_GEMM - 1); PHASE_END
#endif
    PHASE_BEGIN DA_ATTN(1, 0.55605820924f, 0); PHASE_END
    PHASE_BEGIN GEMM_OUT(WS_W_DA1_OUT, args.out); PHASE_END
    PHASE_BEGIN final_norm_rows(args.out, args.final_g, gw, NGW, lane); PHASE_END
}

extern "C" void kernel_launch(void* const* d_in, const int* in_sizes, int n_in, void* d_out, int out_size, void* d_ws, size_t ws_size, hipStream_t stream) {
    static int grid = 0;
    if (grid == 0) {
        if (n_in != 15 || out_size != TOK * DM || ws_size < WS_END) { fprintf(stderr, "kernel_launch: unexpected problem (n_in %d out %d ws %zu)\n", n_in, out_size, ws_size); grid = -1; return; }
        int dev = 0, cus = 0, per_cu = 0;
        hipGetDevice(&dev); hipDeviceGetAttribute(&cus, hipDeviceAttributeMultiprocessorCount, dev);
        if (hipFuncSetAttribute((const void*)hybrid_fwd, hipFuncAttributeMaxDynamicSharedMemorySize, LDS_BYTES) != hipSuccess) { fprintf(stderr, "kernel_launch: hipFuncSetAttribute failed\n"); grid = -1; return; }
        hipOccupancyMaxActiveBlocksPerMultiprocessor(&per_cu, (const void*)hybrid_fwd, 512, LDS_BYTES);
        (void)hipGetLastError();
        if (per_cu < 1) per_cu = 1;
        grid = cus * 1;
        fprintf(stderr, "kernel_launch: %d CUs, occupancy query %d block(s)/CU, grid %d\n", cus, per_cu, grid);
    }
    if (grid < 0) return;
    if (hipMemsetAsync((char*)d_ws + 4096, 0, 16384, stream) != hipSuccess) { fprintf(stderr, "kernel_launch: memset of the barrier words failed\n"); return; }
    Args a{};
    a.x = (const float*)d_in[0]; a.pos = (const int*)d_in[1]; a.norm_g = (const float*)d_in[2]; a.final_g = (const float*)d_in[3];
    a.da_w_in = (const float*)d_in[4]; a.da_w_out = (const float*)d_in[5]; a.da_lambda = (const float*)d_in[6]; a.da_subln = (const float*)d_in[7];
    a.sw_w_in = (const float*)d_in[8]; a.sw_w_out = (const float*)d_in[9]; a.sw_sinks = (const float*)d_in[10];
    a.ml_w_in = (const float*)d_in[11]; a.ml_b_gates = (const float*)d_in[12]; a.ml_w_out = (const float*)d_in[13]; a.ml_norm_g = (const float*)d_in[14];
    a.out = (float*)d_out; a.ws = (unsigned char*)d_ws;
#if MK_LAUNCHES == 1
    a.ph_lo = 0; a.ph_hi = N_PHASES;
    { void* kargs[] = {&a}; hipError_t e = hipLaunchCooperativeKernel((const void*)hybrid_fwd, dim3(grid), dim3(512), kargs, LDS_BYTES, stream);
      if (e != hipSuccess) fprintf(stderr, "cooperative launch failed: %s (grid %d)\n", hipGetErrorString(e), grid); }
#else
    for (int p = 0; p < N_PHASES; ++p) { a.ph_lo = p; a.ph_hi = p + 1; void* kargs[] = {&a};
        hipError_t e = hipLaunchCooperativeKernel((const void*)hybrid_fwd, dim3(grid), dim3(512), kargs, LDS_BYTES, stream);
        if (e != hipSuccess) { fprintf(stderr, "cooperative launch %d failed: %s (grid %d)\n", p, hipGetErrorString(e), grid); break; } }
#endif
}
```
